# Optimizing an MI355X kernel written in HIP

```python
import jax, jax.numpy as jnp
from jax import lax
import numpy as np

D_MODEL = 1024
BATCH = 2
SEQ = 8192
DEPTH = 1
DEC_BATCH = 128
DEC_SEQ = 8
PAST_LEN = 8192
PAGE_SIZE = 128

HEAD_DIM = 64
N_GMLP_GROUPS = 6
GMLP_WIDTH = N_GMLP_GROUPS * HEAD_DIM
CHUNK = 128
DIL_PAIRS = ((128, 1), (512, 4), (2048, 16))
HEADS_PER_DIL = 2
ATTN_HEADS = len(DIL_PAIRS) * HEADS_PER_DIL
ATTN_WIDTH = ATTN_HEADS * HEAD_DIM
N_MEM = 256
MEM_HEADS = 4
MEM_WIDTH = MEM_HEADS * HEAD_DIM
MIX_WIDTH = GMLP_WIDTH + ATTN_WIDTH + MEM_WIDTH
N_IN = 3 * GMLP_WIDTH + 4 * ATTN_WIDTH + 2 * MEM_WIDTH
ROPE_THETA = 500000.0
ROT_DIM = HEAD_DIM // 4
EPS = 1e-6
NEG = -1e30
SCALE = HEAD_DIM ** -0.5

kernel_name = "hybrid_gmlp_dilated_memory_step"


def rms_norm(x, g):
    xf = x.astype(jnp.float32)
    y = xf * lax.rsqrt(jnp.mean(xf * xf, axis=-1, keepdims=True) + EPS)
    return (y * g.astype(jnp.float32)).astype(x.dtype)


def layer_norm(x, g, b):
    xf = x.astype(jnp.float32)
    mu = jnp.mean(xf, axis=-1, keepdims=True)
    var = jnp.mean(jnp.square(xf - mu), axis=-1, keepdims=True)
    y = (xf - mu) * lax.rsqrt(var + EPS) * g.astype(jnp.float32) + b.astype(jnp.float32)
    return y.astype(x.dtype)


def rotary(x, pos):
    half = ROT_DIM // 2
    inv = ROPE_THETA ** (-jnp.arange(half, dtype=jnp.float32) * 2.0 / ROT_DIM)
    ang = pos.astype(jnp.float32)[:, None] * inv[None, :]
    cos = jnp.cos(ang)[None, :, None, :]
    sin = jnp.sin(ang)[None, :, None, :]
    xf = x.astype(jnp.float32)
    x1, x2 = xf[..., :half], xf[..., half:ROT_DIM]
    out = jnp.concatenate([x1 * cos - x2 * sin, x2 * cos + x1 * sin, xf[..., ROT_DIM:]], axis=-1)
    return out.astype(x.dtype)


def mixer_inputs(x, pos, norm_gain, w_in, ln_g, ln_b, q_norm, k_norm, mem_q_norm):
    bx, t, _ = x.shape
    z = jnp.einsum('btd,dn->btn', rms_norm(x, norm_gain), w_in)
    sizes = (GMLP_WIDTH,) * 3 + (ATTN_WIDTH,) * 4 + (MEM_WIDTH,) * 2
    u, v, ga, q, k, vv, gb, qc, gc = jnp.split(z, np.cumsum(sizes)[:-1].tolist(), axis=-1)
    u = jax.nn.gelu(u, approximate=False)
    v = layer_norm(jax.nn.gelu(v, approximate=False), ln_g, ln_b).reshape(bx, t, N_GMLP_GROUPS, HEAD_DIM)
    q = rotary(rms_norm(q.reshape(bx, t, ATTN_HEADS, HEAD_DIM), q_norm), pos)
    k = rotary(rms_norm(k.reshape(bx, t, ATTN_HEADS, HEAD_DIM), k_norm), pos)
    vv = vv.reshape(bx, t, ATTN_HEADS, HEAD_DIM)
    qc = rms_norm(qc.reshape(bx, t, MEM_HEADS, HEAD_DIM), mem_q_norm)
    return u, v, ga, q, k, vv, gb, qc, gc


def gmlp_spatial(v, w_s, b_s):
    b, t, g, dg = v.shape
    nc = -(-t // CHUNK)
    tp = nc * CHUNK
    vp = jnp.pad(v, ((0, 0), (0, tp - t), (0, 0), (0, 0))).reshape(b, nc, CHUNK, g, dg)
    mask = jnp.tril(jnp.ones((CHUNK, CHUNK), dtype=bool))
    ws = jnp.where(mask[None], w_s, 0).astype(v.dtype)
    s = jnp.einsum('gts,bnsgd->bntgd', ws, vp) + b_s.T[None, None, :, :, None].astype(v.dtype)
    return s.reshape(b, tp, g, dg)[:, :t]


def dilated_attn_full(q, k, v, window, dil):
    b, s, h, dh = q.shape
    blk = window // dil
    sp = -(-s // window) * window
    nb = sp // window

    def to_blocks(x):
        x = jnp.pad(x, ((0, 0), (0, sp - s), (0, 0), (0, 0)))
        x = x.reshape(b, sp // dil, dil, h, dh).transpose(0, 2, 1, 3, 4)
        return x.reshape(b, dil, nb, blk, h, dh)

    def with_prev(x):
        prev = jnp.pad(x, ((0, 0), (0, 0), (1, 0), (0, 0), (0, 0), (0, 0)))[:, :, :-1]
        return jnp.concatenate([prev, x], axis=3)

    qb = to_blocks(q)
    kk = with_prev(to_blocks(k))
    vv = with_prev(to_blocks(v))
    sc = jnp.einsum('brnqhe,brnkhe->brnhqk', qb, kk).astype(jnp.float32) * SCALE
    qo = jnp.arange(blk)[:, None]
    ko = jnp.arange(2 * blk)[None, :]
    m = qo + blk - ko
    n = jnp.arange(nb)[:, None, None]
    valid = (m >= 0) & (m <= blk) & ((n * blk + qo - m) >= 0)
    sc = jnp.where(valid[None, None, :, None], sc, NEG)
    lse = jax.nn.logsumexp(sc, axis=-1)
    p = jnp.exp(sc - lse[..., None]).astype(v.dtype)
    o = jnp.einsum('brnhqk,brnkhe->brnqhe', p, vv)
    o = o.reshape(b, dil, sp // dil, h, dh).transpose(0, 2, 1, 3, 4).reshape(b, sp, h, dh)[:, :s]
    lse = lse.transpose(0, 1, 2, 4, 3).reshape(b, dil, sp // dil, h)
    lse = lse.transpose(0, 2, 1, 3).reshape(b, sp, h)[:, :s]
    return o, lse


def dilated_attn_step(q, kv_buf, k_new, v_new, window, dil):
    l = kv_buf.shape[1]
    t = q.shape[1]
    kc = jnp.concatenate([kv_buf[:, :, 0], k_new.astype(kv_buf.dtype)], axis=1)
    vc = jnp.concatenate([kv_buf[:, :, 1], v_new.astype(kv_buf.dtype)], axis=1)
    nk = window // dil + 1
    idx = l + jnp.arange(t)[:, None] - dil * jnp.arange(nk)[None, :]
    valid = idx >= 0
    idx = jnp.maximum(idx, 0)
    kg = kc[:, idx]
    vg = vc[:, idx]
    sc = jnp.einsum('bthe,btmhe->bthm', q, kg).astype(jnp.float32) * SCALE
    sc = jnp.where(valid[None, :, None, :], sc, NEG)
    lse = jax.nn.logsumexp(sc, axis=-1)
    p = jnp.exp(sc - lse[..., None]).astype(vg.dtype)
    o = jnp.einsum('bthm,btmhe->bthe', p, vg)
    new_buf = jnp.stack([kc, vc], axis=2)[:, kc.shape[1] - l:]
    return o, lse, new_buf


def combine_dilations(outs, lses):
    o = jnp.stack(outs, axis=2)
    a = jax.nn.softmax(jnp.stack(lses, axis=2).astype(jnp.float32), axis=2)
    b, t = o.shape[:2]
    return (o * a[..., None].astype(o.dtype)).reshape(b, t, ATTN_WIDTH)


def mem_keys_values(mem, mem_norm, w_mem_kv, mem_k_norm):
    b, n, _ = mem.shape
    kv = jnp.einsum('bmd,dn->bmn', rms_norm(mem, mem_norm), w_mem_kv).reshape(b, n, 2, MEM_HEADS, HEAD_DIM)
    return jnp.stack([rms_norm(kv[:, :, 0], mem_k_norm), kv[:, :, 1]], axis=2)


def mem_attention(q, kv):
    sc = jnp.einsum('bthe,bmhe->bhtm', q, kv[:, :, 0]).astype(jnp.float32) * SCALE
    p = jax.nn.softmax(sc, axis=-1).astype(kv.dtype)
    o = jnp.einsum('bhtm,bmhe->bthe', p, kv[:, :, 1])
    return o.reshape(q.shape[0], q.shape[1], MEM_WIDTH)


def layer_output(x, a, b, c, ga, gb, gc, w_out):
    mix = jnp.concatenate([a * jax.nn.silu(ga), b * jax.nn.silu(gb), c * jax.nn.silu(gc)], axis=-1)
    return x + jnp.einsum('btn,nd->btd', mix, w_out)


def setup_inputs(seed: int = 0) -> dict:
    key = jax.random.key(seed)
    ks = jax.random.split(key, 24)
    f32 = jnp.float32
    nrm = lambda k, shp: jax.random.normal(k, shp, dtype=f32)
    gain = lambda k, shp: 1.0 + 0.02 * nrm(k, shp)
    win_len = [min(w, PAST_LEN) for (w, _) in DIL_PAIRS]
    return {
        "x_prompt": nrm(ks[0], (BATCH, SEQ, D_MODEL)),
        "x_sample": nrm(ks[1], (DEC_BATCH, DEC_SEQ, D_MODEL)),
        "state_win0_kv": nrm(ks[2], (DEPTH, DEC_BATCH, win_len[0], 2, HEADS_PER_DIL, HEAD_DIM)),
        "state_win1_kv": nrm(ks[3], (DEPTH, DEC_BATCH, win_len[1], 2, HEADS_PER_DIL, HEAD_DIM)),
        "state_win2_kv": nrm(ks[4], (DEPTH, DEC_BATCH, win_len[2], 2, HEADS_PER_DIL, HEAD_DIM)),
        "cache_mem_kv": nrm(ks[5], (DEPTH, DEC_BATCH, N_MEM, 2, MEM_HEADS, HEAD_DIM)),
        "mem_prompt": nrm(ks[6], (BATCH, N_MEM, D_MODEL)),
        "norm_gain": gain(ks[7], (DEPTH, D_MODEL)),
        "w_in": nrm(ks[8], (DEPTH, D_MODEL, N_IN)) * D_MODEL ** -0.5,
        "gmlp_ln_gain": gain(ks[9], (DEPTH, GMLP_WIDTH)),
        "gmlp_ln_bias": 0.02 * nrm(ks[10], (DEPTH, GMLP_WIDTH)),
        "gmlp_w_s": nrm(ks[11], (DEPTH, N_GMLP_GROUPS, CHUNK, CHUNK)) * CHUNK ** -0.5,
        "gmlp_b_s": 1.0 + 0.02 * nrm(ks[12], (DEPTH, N_GMLP_GROUPS, CHUNK)),
        "attn_q_norm": gain(ks[13], (DEPTH, HEAD_DIM)),
        "attn_k_norm": gain(ks[14], (DEPTH, HEAD_DIM)),
        "mem_norm": gain(ks[15], (DEPTH, D_MODEL)),
        "w_mem_kv": nrm(ks[16], (DEPTH, D_MODEL, 2 * MEM_WIDTH)) * D_MODEL ** -0.5,
        "mem_q_norm": gain(ks[17], (DEPTH, HEAD_DIM)),
        "mem_k_norm": gain(ks[18], (DEPTH, HEAD_DIM)),
        "w_out": nrm(ks[19], (DEPTH, MIX_WIDTH, D_MODEL)) * MIX_WIDTH ** -0.5,
    }


def reference(x_prompt, x_sample, state_win0_kv, state_win1_kv, state_win2_kv, cache_mem_kv,
              mem_prompt, norm_gain, w_in, gmlp_ln_gain, gmlp_ln_bias, gmlp_w_s, gmlp_b_s,
              attn_q_norm, attn_k_norm, mem_norm, w_mem_kv, mem_q_norm, mem_k_norm, w_out):
    bp, s, _ = x_prompt.shape
    bd, t, _ = x_sample.shape
    pos_p = jnp.arange(s, dtype=jnp.int32)
    pos_s = PAST_LEN + jnp.arange(t, dtype=jnp.int32)
    win_in = (state_win0_kv, state_win1_kv, state_win2_kv)
    hp, hs = x_prompt, x_sample
    win_p = [[] for _ in DIL_PAIRS]
    win_s = [[] for _ in DIL_PAIRS]
    mem_p, gv_s = [], []
    for l in range(DEPTH):
        proj = (norm_gain[l], w_in[l], gmlp_ln_gain[l], gmlp_ln_bias[l],
                attn_q_norm[l], attn_k_norm[l], mem_q_norm[l])
        u, v, ga, q, k, vv, gb, qc, gc = mixer_inputs(hp, pos_p, *proj)
        a = u * gmlp_spatial(v, gmlp_w_s[l], gmlp_b_s[l]).reshape(bp, s, GMLP_WIDTH)
        outs, lses = [], []
        for g, (w, d) in enumerate(DIL_PAIRS):
            hsl = slice(g * HEADS_PER_DIL, (g + 1) * HEADS_PER_DIL)
            o, lse = dilated_attn_full(q[:, :, hsl], k[:, :, hsl], vv[:, :, hsl], w, d)
            outs.append(o)
            lses.append(lse)
            win_p[g].append(jnp.stack([k[:, :, hsl], vv[:, :, hsl]], axis=2)[:, s - min(w, s):])
        bo = combine_dilations(outs, lses)
        mkv = mem_keys_values(mem_prompt, mem_norm[l], w_mem_kv[l], mem_k_norm[l])
        mem_p.append(mkv)
        c = mem_attention(qc, mkv)
        hp = layer_output(hp, a, bo, c, ga, gb, gc, w_out[l])
        u, v, ga, q, k, vv, gb, qc, gc = mixer_inputs(hs, pos_s, *proj)
        a = u * gmlp_spatial(v, gmlp_w_s[l], gmlp_b_s[l]).reshape(bd, t, GMLP_WIDTH)
        gv_s.append(v)
        outs, lses = [], []
        for g, (w, d) in enumerate(DIL_PAIRS):
            hsl = slice(g * HEADS_PER_DIL, (g + 1) * HEADS_PER_DIL)
            o, lse, nbuf = dilated_attn_step(q[:, :, hsl], win_in[g][l], k[:, :, hsl], vv[:, :, hsl], w, d)
            outs.append(o)
            lses.append(lse)
            win_s[g].append(nbuf)
        bo = combine_dilations(outs, lses)
        c = mem_attention(qc, cache_mem_kv[l])
        hs = layer_output(hs, a, bo, c, ga, gb, gc, w_out[l])
    new_win0_p = jnp.stack(win_p[0])
    new_win1_p = jnp.stack(win_p[1])
    new_win2_p = jnp.stack(win_p[2])
    new_mem_kv_p = jnp.stack(mem_p)
    new_win0_s = jnp.stack(win_s[0])
    new_win1_s = jnp.stack(win_s[1])
    new_win2_s = jnp.stack(win_s[2])
    new_gmlp_v_s = jnp.stack(gv_s)
    return (hp, hs, new_win0_p, new_win1_p, new_win2_p, new_mem_kv_p,
            new_win0_s, new_win1_s, new_win2_s, new_gmlp_v_s)
```

```cpp
#include <hip/hip_runtime.h>
#include <hip/hip_bf16.h>
#include <hip/hip_cooperative_groups.h>
#include <cstdio>
namespace cg = cooperative_groups;

typedef __attribute__((ext_vector_type(8))) short bf16x8;
typedef __attribute__((ext_vector_type(4))) short s16x4;
typedef __attribute__((ext_vector_type(4))) float f32x4;
typedef unsigned short u16;
#define DEVI __device__ __forceinline__
#define LAS __attribute__((address_space(3)))
#define GAS __attribute__((address_space(1)))
#define NT 512

constexpr int PROWS = 16384, SROWS = 1024, ROWS = 17408, SEQ = 8192;
constexpr float EPS = 1e-6f;
constexpr float NEGV = -1e30f;
constexpr float QSCALE = 0.125f;

constexpr long O_YP = 0;
constexpr long O_YS = 16777216;
constexpr long O_W0P = O_YS + 1048576;
constexpr long O_W1P = O_W0P + 65536;
constexpr long O_W2P = O_W1P + 262144;
constexpr long O_MKV = O_W2P + 1048576;
constexpr long O_W0S = O_MKV + 262144;
constexpr long O_W1S = O_W0S + 4194304;
constexpr long O_W2S = O_W1S + 16777216;
constexpr long O_GV = O_W2S + 67108864;

constexpr size_t A256(size_t x) { return (x + 255) & ~(size_t)255; }
constexpr size_t W_XB = 0;
constexpr size_t W_MEMB = A256(W_XB + (size_t)ROWS * 1024 * 2);
constexpr size_t W_RSTD = A256(W_MEMB + 512 * 1024 * 2);
constexpr size_t W_WINT = A256(W_RSTD + (ROWS + 512) * 4);
constexpr size_t W_WOUTT = A256(W_WINT + 3328 * 1024 * 2);
constexpr size_t W_WMEMT = A256(W_WOUTT + 1024 * 1024 * 2);
constexpr size_t W_WSB = A256(W_WMEMT + 512 * 1024 * 2);
constexpr size_t W_ROPE = A256(W_WSB + 6 * 128 * 128 * 2);
constexpr size_t W_U = A256(W_ROPE + 8200 * 8 * 8);
constexpr size_t W_GV = A256(W_U + (size_t)ROWS * 384 * 2);
constexpr size_t W_VSTAT = A256(W_GV + (size_t)ROWS * 384 * 2);
constexpr size_t W_SGA = A256(W_VSTAT + (size_t)ROWS * 12 * 4);
constexpr size_t W_QP = A256(W_SGA + (size_t)ROWS * 384 * 2);
constexpr size_t W_KP = A256(W_QP + 2 * 6 * 8192 * 64 * 2);
constexpr size_t W_VP = A256(W_KP + 2 * 6 * 8192 * 64 * 2);
constexpr size_t W_QS = A256(W_VP + 2 * 6 * 8192 * 64 * 2);
constexpr size_t W_SGB = A256(W_QS + 1024 * 384 * 4);
constexpr size_t W_QC = A256(W_SGB + (size_t)ROWS * 384 * 2);
constexpr size_t W_QCS = A256(W_QC + 16384 * 256 * 2);
constexpr size_t W_SGC = A256(W_QCS + 1024 * 256 * 4);
constexpr size_t W_MK = A256(W_SGC + (size_t)ROWS * 256 * 2);
constexpr size_t W_MV = A256(W_MK + 2 * 4 * 256 * 64 * 2);
constexpr size_t W_O = A256(W_MV + 2 * 4 * 256 * 64 * 2);
constexpr size_t W_LSE = A256(W_O + (size_t)ROWS * 384 * 2);
constexpr size_t W_MIX = A256(W_LSE + (size_t)ROWS * 6 * 4);
constexpr size_t W_CTL = A256(W_MIX + (size_t)ROWS * 1024 * 2);
constexpr size_t CTL_BYTES = 16384;
constexpr size_t W_END = A256(W_CTL + CTL_BYTES);

constexpr int LDS_BYTES = 131072;
constexpr int KSTR = 144, VSTR = 160;

struct Params {
  const float *x_prompt, *x_sample, *st0, *st1, *st2, *cache_mem, *mem_prompt, *norm_gain, *w_in, *ln_g, *ln_b,
      *w_s, *b_s, *q_norm, *k_norm, *mem_norm, *w_mem_kv, *mem_q_norm, *mem_k_norm, *w_out;
  float* out;
  char* ws;
  long phase_lo, phase_hi;
};

typedef __attribute__((ext_vector_type(2))) __bf16 bf16x2_t;
typedef __attribute__((ext_vector_type(2))) float f32x2_t;
DEVI unsigned pk2(float a, float b) {
  f32x2_t v = {a, b};
  return __builtin_bit_cast(unsigned, __builtin_convertvector(v, bf16x2_t));
}
DEVI u16 f2bf(float a) { return (u16)(pk2(a, 0.f) & 0xffffu); }
DEVI float bf2f(unsigned v) { return __uint_as_float(v << 16); }
DEVI float bflo(unsigned v) { return __uint_as_float(v << 16); }
DEVI float bfhi(unsigned v) { return __uint_as_float(v & 0xffff0000u); }
DEVI float gelu_f(float x) {
  const float z = fabsf(x) * 0.70710678118654752f;
  const float t = __builtin_amdgcn_rcpf(1.f + 0.3275911f * z);
  float poly = 1.061405429f;
  poly = poly * t - 1.453152027f;
  poly = poly * t + 1.421413741f;
  poly = poly * t - 0.284496736f;
  poly = poly * t + 0.254829592f;
  poly *= t;
  const float e = 1.f - poly * __expf(-z * z);
  const float erfv = x < 0.f ? -e : e;
  return 0.5f * x * (1.f + erfv);
}
DEVI float silu_f(float x) { return x * __builtin_amdgcn_rcpf(1.f + __expf(-x)); }
DEVI float red16(float x) {
  x += __builtin_bit_cast(float, __builtin_amdgcn_update_dpp(0, __builtin_bit_cast(int, x), 0xB1, 0xF, 0xF, true));
  x += __builtin_bit_cast(float, __builtin_amdgcn_update_dpp(0, __builtin_bit_cast(int, x), 0x4E, 0xF, 0xF, true));
  x += __builtin_bit_cast(float, __builtin_amdgcn_update_dpp(0, __builtin_bit_cast(int, x), 0x124, 0xF, 0xF, true));
  x += __builtin_bit_cast(float, __builtin_amdgcn_update_dpp(0, __builtin_bit_cast(int, x), 0x128, 0xF, 0xF, true));
  return x;
}
DEVI float max16(float x) {
  x = fmaxf(x, __builtin_bit_cast(float, __builtin_amdgcn_update_dpp(0, __builtin_bit_cast(int, x), 0xB1, 0xF, 0xF, true)));
  x = fmaxf(x, __builtin_bit_cast(float, __builtin_amdgcn_update_dpp(0, __builtin_bit_cast(int, x), 0x4E, 0xF, 0xF, true)));
  x = fmaxf(x, __builtin_bit_cast(float, __builtin_amdgcn_update_dpp(0, __builtin_bit_cast(int, x), 0x124, 0xF, 0xF, true)));
  x = fmaxf(x, __builtin_bit_cast(float, __builtin_amdgcn_update_dpp(0, __builtin_bit_cast(int, x), 0x128, 0xF, 0xF, true)));
  return x;
}
DEVI float wave_sum(float v) {
  v = red16(v);
  v += __shfl_xor(v, 16);
  v += __shfl_xor(v, 32);
  return v;
}
DEVI float wave_max(float v) {
  v = max16(v);
  v = fmaxf(v, __shfl_xor(v, 16));
  v = fmaxf(v, __shfl_xor(v, 32));
  return v;
}
DEVI f32x4 mfma16(bf16x8 a, bf16x8 b, f32x4 c) { return __builtin_amdgcn_mfma_f32_16x16x32_bf16(a, b, c, 0, 0, 0); }
DEVI s16x4 tr_read(const char* p) { return __builtin_amdgcn_ds_read_tr16_b64_v4i16((LAS s16x4*)p); }
DEVI bf16x8 cat8(s16x4 lo, s16x4 hi) { return (bf16x8){lo[0], lo[1], lo[2], lo[3], hi[0], hi[1], hi[2], hi[3]}; }


#define XB_TMO 128
#define XB_XCNT(j) (256 + 64 * (j))
#define XB_XSUB(j) (1280 + 64 * (j))
#define XB_XGEN(j) (2304 + 64 * (j))
#define XB_TOP 3328
#define XB_TOPGEN 3392
#define XCD_BAR_WORDS 3456
#define CTL_COPY_HEAD 3520
#define CTL_P1_DONE 3584
#define CTL_P4_DONE 3648
#define XB_SPIN_CAP (1u << 18)
DEVI unsigned xb_ld(unsigned* p) { return __hip_atomic_load(p, __ATOMIC_RELAXED, __HIP_MEMORY_SCOPE_AGENT); }
DEVI unsigned xb_add(unsigned* p, unsigned v) { return __hip_atomic_fetch_add(p, v, __ATOMIC_RELAXED, __HIP_MEMORY_SCOPE_AGENT); }
DEVI unsigned xb_xcc_id() { return (unsigned)__builtin_amdgcn_s_getreg((3 << 11) | 20) & 0xFu; }
#define XB_SPIN(cond, bar)                                                                    \
  do {                                                                                        \
    unsigned _sp = 0;                                                                         \
    while (cond) {                                                                            \
      __builtin_amdgcn_s_sleep(1);                                                            \
      if ((++_sp & 255u) == 0u) {                                                             \
        if (xb_ld(&(bar)[XB_TMO])) break;                                                     \
        if (_sp > XB_SPIN_CAP) { atomicAdd(&(bar)[XB_TMO], 1u); break; }                      \
      }                                                                                       \
    }                                                                                         \
  } while (0)
struct XcdBarrier { unsigned* bar; unsigned x; volatile LAS unsigned* st; };
DEVI XcdBarrier xcd_barrier_post(unsigned* bar, volatile LAS unsigned* st) {
  XcdBarrier b; b.bar = bar; b.x = xb_xcc_id(); b.st = st;
  if (threadIdx.x == 0) (void)xb_add(&bar[XB_XCNT(b.x)], 1u);
  return b;
}
DEVI void xcd_barrier_complete(unsigned* bar, unsigned x, unsigned& nloc, unsigned& nx) {
  const unsigned G = gridDim.x * gridDim.y * gridDim.z;
  unsigned sum, cnt, mine, sp = 0u;
  for (;;) {
    sum = 0u; cnt = 0u; mine = 0u;
#pragma unroll
    for (unsigned j = 0; j < 16; ++j) { const unsigned c = xb_ld(&bar[XB_XCNT(j)]); sum += c; cnt += (c > 0u) ? 1u : 0u; mine = (j == x) ? c : mine; }
    if (sum == G) break;
    __builtin_amdgcn_s_sleep(1);
    if ((++sp & 255u) == 0u) { if (xb_ld(&bar[XB_TMO])) break; if (sp > XB_SPIN_CAP) { atomicAdd(&bar[XB_TMO], 1u); break; } }
  }
  nloc = mine > 0u ? mine : 1u; nx = cnt > 0u ? cnt : 1u;
}
DEVI void xcd_barrier(const XcdBarrier& b) {
  asm volatile("s_waitcnt vmcnt(0)" ::: "memory");
  __syncthreads();
  if (threadIdx.x == 0) {
    unsigned* bar = b.bar;
    __builtin_amdgcn_s_waitcnt(0);
    unsigned nloc = b.st[0], nx = b.st[1];
    if (nloc == 0u) { xcd_barrier_complete(bar, b.x, nloc, nx); b.st[0] = nloc; b.st[1] = nx; }
    const unsigned old = xb_add(&bar[XB_XSUB(b.x)], 1u);
    const unsigned gen = old / nloc;
    if (old + 1u == (gen + 1u) * nloc) {
      __builtin_amdgcn_fence(__ATOMIC_RELEASE, "agent");
      asm volatile("s_waitcnt vmcnt(0)" ::: "memory");
      const unsigned og = xb_add(&bar[XB_TOP], 1u);
      const unsigned tg = og / nx;
      if (og + 1u == (tg + 1u) * nx) xb_add(&bar[XB_TOPGEN], 1u);
      else XB_SPIN(xb_ld(&bar[XB_TOPGEN]) == tg, bar);
      __builtin_amdgcn_fence(__ATOMIC_ACQUIRE, "agent");
      xb_add(&bar[XB_XGEN(b.x)], 1u);
      asm volatile("s_waitcnt vmcnt(0)" ::: "memory");
    } else {
      XB_SPIN(xb_ld(&bar[XB_XGEN(b.x)]) == gen, bar);
      __builtin_amdgcn_fence(__ATOMIC_ACQUIRE, "agent");
      asm volatile("s_waitcnt vmcnt(0)" ::: "memory");
    }
  }
  __syncthreads();
}

DEVI void gemm256(const u16* __restrict__ A, const u16* __restrict__ Bt, f32x4 (&acc)[2][2][4][2], char* shm, const int tid) {
  constexpr int K = 1024, BK = 64, HALF = 128;
  const int lane = tid & 63, wid = tid >> 6, wr = wid >> 2, wc = wid & 3, fr = lane & 15, fq = lane >> 4;
#define SA(b, h) (shm + ((b) * 2 + (h)) * 16384)
#define SB(b, h) (shm + (4 + (b) * 2 + (h)) * 16384)
  int sb_[2], go_[2];
#pragma unroll
  for (int i = 0; i < 2; ++i) {
    int b = tid * 16 + i * 8192;
    int st = b >> 10, sbb = b & 1023, swz = sbb ^ (((sbb >> 9) & 1) << 5);
    int R = (st >> 1) * 16 + (swz >> 6), C = (st & 1) * 32 + ((swz & 63) >> 1);
    sb_[i] = b; go_[i] = R * K + C;
  }
#define STAGE(P, BASE, br, kt)                                                                                          \
  do {                                                                                                                  \
    _Pragma("unroll") for (int _i = 0; _i < 2; ++_i) __builtin_amdgcn_global_load_lds(                                   \
        (const unsigned*)((BASE) + (long)(br) * K + (kt) * BK + go_[_i]), (LAS unsigned*)((P) + sb_[_i]), 16, 0, 0);     \
  } while (0)
  const int obs = (fr * 64 + fq * 16) ^ (((fr >> 3) & 1) << 5);
  const int aoff = wr * 8192 + obs, boff = wc * 4096 + obs;
#define LDA(dst, b, h)                                                                                  \
  _Pragma("unroll") for (int m = 0; m < 4; ++m) _Pragma("unroll") for (int k = 0; k < 2; ++k) dst[m][k] = \
      *(const bf16x8*)(SA(b, h) + aoff + (m * 2 + k) * 1024)
#define LDB(dst, b, h)                                                                                  \
  _Pragma("unroll") for (int n = 0; n < 2; ++n) _Pragma("unroll") for (int k = 0; k < 2; ++k) dst[n][k] = \
      *(const bf16x8*)(SB(b, h) + boff + (n * 2 + k) * 1024)
#define MMA(ai, bj, At, Bx)                                                                                             \
  do {                                                                                                                  \
    __builtin_amdgcn_s_setprio(1);                                                                                      \
    _Pragma("unroll") for (int m = 0; m < 4; ++m) _Pragma("unroll") for (int n = 0; n < 2; ++n) _Pragma("unroll") for ( \
        int k = 0; k < 2; ++k) acc[ai][bj][m][n] = mfma16(At[m][k], Bx[n][k], acc[ai][bj][m][n]);                        \
    __builtin_amdgcn_s_setprio(0);                                                                                      \
  } while (0)
#define WAIT_V(n) asm volatile("s_waitcnt vmcnt(" #n ")" ::: "memory")
#define WAIT_L(n) asm volatile("s_waitcnt lgkmcnt(" #n ")" ::: "memory")
#define BAR __builtin_amdgcn_s_barrier()
#define SCHED __builtin_amdgcn_sched_barrier(0)
#pragma unroll
  for (int a = 0; a < 2; ++a)
#pragma unroll
    for (int b = 0; b < 2; ++b)
#pragma unroll
      for (int m = 0; m < 4; ++m)
#pragma unroll
        for (int n = 0; n < 2; ++n) acc[a][b][m][n] = (f32x4){0.f, 0.f, 0.f, 0.f};
  bf16x8 At[4][2], B0[2][2], B1[2][2];
  constexpr int nt = K / BK;
  WAIT_V(0);
  STAGE(SB(0, 0), Bt, 0, 0); STAGE(SA(0, 0), A, 0, 0);
  STAGE(SB(0, 1), Bt, HALF, 0); STAGE(SA(0, 1), A, HALF, 0);
  if (wr == 1) BAR;
  WAIT_V(4); BAR;
  STAGE(SB(1, 0), Bt, 0, 1); STAGE(SA(1, 0), A, 0, 1); STAGE(SB(1, 1), Bt, HALF, 1);
  WAIT_V(6); BAR;
#pragma unroll 1
  for (int t = 0; t < nt - 2; t += 2) {
    LDB(B0, 0, 0); SCHED; LDA(At, 0, 0); STAGE(SA(1, 1), A, HALF, t + 1);
    WAIT_L(8); BAR; WAIT_L(0); MMA(0, 0, At, B0); BAR; SCHED;
    LDB(B1, 0, 1); STAGE(SB(0, 0), Bt, 0, t + 2);
    BAR; WAIT_L(0); MMA(0, 1, At, B1); BAR;
    LDA(At, 0, 1); STAGE(SA(0, 0), A, 0, t + 2);
    BAR; WAIT_L(0); MMA(1, 0, At, B0); BAR; SCHED;
    STAGE(SB(0, 1), Bt, HALF, t + 2);
    WAIT_V(6); BAR; MMA(1, 1, At, B1); BAR;
    LDB(B0, 1, 0); SCHED; LDA(At, 1, 0); STAGE(SA(0, 1), A, HALF, t + 2);
    WAIT_L(8); BAR; WAIT_L(0); MMA(0, 0, At, B0); BAR; SCHED;
    LDB(B1, 1, 1); STAGE(SB(1, 0), Bt, 0, t + 3);
    BAR; WAIT_L(0); MMA(0, 1, At, B1); BAR;
    LDA(At, 1, 1); STAGE(SA(1, 0), A, 0, t + 3);
    BAR; WAIT_L(0); MMA(1, 0, At, B0); BAR; SCHED;
    STAGE(SB(1, 1), Bt, HALF, t + 3);
    WAIT_V(6); BAR; MMA(1, 1, At, B1); BAR;
  }
  {
    LDB(B0, 0, 0); LDA(At, 0, 0); STAGE(SA(1, 1), A, HALF, nt - 1);
    BAR; WAIT_L(0); MMA(0, 0, At, B0); BAR;
    LDB(B1, 0, 1); BAR; WAIT_L(0); MMA(0, 1, At, B1); BAR;
    LDA(At, 0, 1); WAIT_V(4); BAR; WAIT_L(0); MMA(1, 0, At, B0); MMA(1, 1, At, B1); BAR;
  }
  {
    LDB(B0, 1, 0); LDA(At, 1, 0); WAIT_V(2); BAR; WAIT_L(0); MMA(0, 0, At, B0); BAR;
    LDB(B1, 1, 1); WAIT_V(0); BAR; WAIT_L(0); MMA(0, 1, At, B1); BAR;
    LDA(At, 1, 1); BAR; WAIT_L(0); MMA(1, 0, At, B0); MMA(1, 1, At, B1); BAR;
  }
  if (wr == 0) BAR;
#undef SA
#undef SB
#undef STAGE
#undef LDA
#undef LDB
#undef MMA
}

DEVI void transpose_w(const float* __restrict__ w, const float* __restrict__ gain, u16* __restrict__ wt, int N, int gtid, int gsz) {
  const int items = N * 128;
  for (int idx = gtid; idx < items; idx += gsz) {
    int n = idx % N, kc = idx / N;
    float v[8];
#pragma unroll
    for (int e = 0; e < 8; ++e) {
      int k = kc * 8 + e;
      float x = w[(long)k * N + n];
      if (gain) x *= gain[k];
      v[e] = x;
    }
    uint4 o = {pk2(v[0], v[1]), pk2(v[2], v[3]), pk2(v[4], v[5]), pk2(v[6], v[7])};
    *(uint4*)(wt + (long)n * 1024 + kc * 8) = o;
  }
}

DEVI void phase0(const Params& p) {
  const int gtid = blockIdx.x * NT + threadIdx.x, gsz = gridDim.x * NT;
  const int gw = gtid >> 6, nw = gsz >> 6, lane = threadIdx.x & 63;
  u16* XB = (u16*)(p.ws + W_XB);
  u16* MEMB = (u16*)(p.ws + W_MEMB);
  float* RSTD = (float*)(p.ws + W_RSTD);
  const float* const xp_ = p.x_prompt; const float* const xs_ = p.x_sample; const float* const mp_ = p.mem_prompt;
  for (int r0 = gw; r0 < ROWS + 512; r0 += 3 * nw) {
    float4 v[3][4];
#pragma unroll
    for (int q = 0; q < 3; ++q) {
      const int r = min(r0 + q * nw, ROWS + 511);
      const float* src = r < PROWS ? xp_ + (long)r * 1024 : (r < ROWS ? xs_ + (long)(r - PROWS) * 1024 : mp_ + (long)(r - ROWS) * 1024);
#pragma unroll
      for (int i = 0; i < 4; ++i) v[q][i] = ((const float4*)src)[i * 64 + lane];
    }
#pragma unroll
    for (int q = 0; q < 3; ++q) {
      const int r = r0 + q * nw;
      if (r < ROWS + 512) {
        u16* dst = r < ROWS ? XB + (long)r * 1024 : MEMB + (long)(r - ROWS) * 1024;
        float ss = 0.f;
#pragma unroll
        for (int i = 0; i < 4; ++i) {
          ss += v[q][i].x * v[q][i].x + v[q][i].y * v[q][i].y + v[q][i].z * v[q][i].z + v[q][i].w * v[q][i].w;
          uint2 o = {pk2(v[q][i].x, v[q][i].y), pk2(v[q][i].z, v[q][i].w)};
          ((uint2*)dst)[i * 64 + lane] = o;
        }
        ss = wave_sum(ss);
        if (lane == 0) RSTD[r] = rsqrtf(ss * (1.f / 1024.f) + EPS);
      }
    }
  }
  transpose_w(p.w_in, p.norm_gain, (u16*)(p.ws + W_WINT), 3200, gtid, gsz);
  {
    uint4* z = (uint4*)(p.ws + W_WINT + (size_t)3200 * 1024 * 2);
    for (int idx = gtid; idx < 128 * 1024 * 2 / 16; idx += gsz) z[idx] = make_uint4(0, 0, 0, 0);
  }
  transpose_w(p.w_out, nullptr, (u16*)(p.ws + W_WOUTT), 1024, gtid, gsz);
  transpose_w(p.w_mem_kv, p.mem_norm, (u16*)(p.ws + W_WMEMT), 512, gtid, gsz);
  u16* WSB = (u16*)(p.ws + W_WSB);
  for (int idx = gtid; idx < 6 * 128 * 128; idx += gsz) {
    int t = (idx >> 7) & 127, s = idx & 127;
    WSB[idx] = (s <= t) ? f2bf(p.w_s[idx]) : (u16)0;
  }
  float2* ROPE = (float2*)(p.ws + W_ROPE);
  for (int idx = gtid; idx < 8200 * 8; idx += gsz) {
    int pos = idx >> 3, i = idx & 7;
    float inv = i == 0 ? 1.0f : i == 1 ? 0.19392274f : i == 2 ? 0.03760603f : i == 3 ? 0.0072926646f : i == 4 ? 0.0014142136f
              : i == 5 ? 0.00027424818f : i == 6 ? 5.3182957e-05f : 1.0313385e-05f;
    float ang = (float)pos * inv;
    float sn, cs;
    sincosf(ang, &sn, &cs);
    ROPE[idx] = make_float2(cs, sn);
  }
}

#define QV(m, np) q[(np) >> 1][m][(np) & 1]
DEVI void epi_act(f32x4 (&q)[2][4][2], const float* rs, u16* dst, int dstride, int col0, int tokb, bool use_gelu, const int lane) {
  const int fq = lane >> 4;
#pragma unroll
  for (int np = 0; np < 4; ++np) {
    long tok = tokb + (np >> 1) * 128 + (np & 1) * 16;
#pragma unroll
    for (int m = 0; m < 4; ++m) {
      float v[4];
#pragma unroll
      for (int j = 0; j < 4; ++j) {
        float x = QV(m, np)[j] * rs[np];
        v[j] = use_gelu ? gelu_f(x) : silu_f(x);
      }
      uint2 o = {pk2(v[0], v[1]), pk2(v[2], v[3])};
      *(uint2*)(dst + tok * dstride + col0 + m * 16 + fq * 4) = o;
    }
  }
}

DEVI void head_norm(f32x4 (&q)[2][4][2], const float* rs, const float* __restrict__ gain, float scale, bool rot, const int* pos,
                    const float2* __restrict__ ROPE, const int lane) {
  const int fq = lane >> 4;
  float g[4][4];
#pragma unroll
  for (int m = 0; m < 4; ++m) {
    float4 gv = *(const float4*)(gain + m * 16 + fq * 4);
    g[m][0] = gv.x * scale; g[m][1] = gv.y * scale; g[m][2] = gv.z * scale; g[m][3] = gv.w * scale;
  }
#pragma unroll
  for (int np = 0; np < 4; ++np) {
    float ss = 0.f;
#pragma unroll
    for (int m = 0; m < 4; ++m)
#pragma unroll
      for (int j = 0; j < 4; ++j) {
        float x = QV(m, np)[j] * rs[np];
        QV(m, np)[j] = x;
        ss += x * x;
      }
    ss += __shfl_xor(ss, 16);
    ss += __shfl_xor(ss, 32);
    float r = rsqrtf(ss * (1.f / 64.f) + EPS);
#pragma unroll
    for (int m = 0; m < 4; ++m)
#pragma unroll
      for (int j = 0; j < 4; ++j) QV(m, np)[j] *= r * g[m][j];
    if (rot) {
#pragma unroll
      for (int j = 0; j < 4; ++j) {
        float x = QV(0, np)[j];
        float y = __shfl_xor(x, 32);
        float2 cs = ROPE[pos[np] * 8 + (fq & 1) * 4 + j];
        QV(0, np)[j] = (fq < 2) ? (x * cs.x - y * cs.y) : (x * cs.x + y * cs.y);
      }
    }
  }
}

DEVI int perm_pos(int t, int sh) { return ((t & ((1 << sh) - 1)) << (13 - sh)) + (t >> sh); }

DEVI void phase1_group(char* ws_, float* out_, const Params& p, f32x4 (&q)[2][4][2], int cg, int tokb, bool sample, const int lane) {
  const int fq = lane >> 4;
  const float* RSTD = (const float*)(ws_ + W_RSTD);
  const float2* ROPE = (const float2*)(ws_ + W_ROPE);
  float rs[4];
  int pos[4];
#pragma unroll
  for (int np = 0; np < 4; ++np) {
    int tok = tokb + (np >> 1) * 128 + (np & 1) * 16;
    rs[np] = RSTD[tok];
    pos[np] = sample ? (SEQ + ((tok - PROWS) & 7)) : (tok & (SEQ - 1));
  }
  if (cg < 6) {
    epi_act(q, rs, (u16*)(ws_ + W_U), 384, cg * 64, tokb, true, lane);
  } else if (cg < 12) {
    u16* GV = (u16*)(ws_ + W_GV);
    float* VSTAT = (float*)(ws_ + W_VSTAT);
#pragma unroll
    for (int np = 0; np < 4; ++np) {
      long tok = tokb + (np >> 1) * 128 + (np & 1) * 16;
      float s1 = 0.f, s2 = 0.f;
#pragma unroll
      for (int m = 0; m < 4; ++m) {
        float v[4];
#pragma unroll
        for (int j = 0; j < 4; ++j) {
          float x = bf2f(f2bf(gelu_f(QV(m, np)[j] * rs[np])));
          v[j] = x; s1 += x; s2 += x * x;
        }
        uint2 o = {pk2(v[0], v[1]), pk2(v[2], v[3])};
        *(uint2*)(GV + tok * 384 + (cg - 6) * 64 + m * 16 + fq * 4) = o;
      }
      s1 += __shfl_xor(s1, 16); s2 += __shfl_xor(s2, 16);
      s1 += __shfl_xor(s1, 32); s2 += __shfl_xor(s2, 32);
      if (fq == 0) *(float2*)(VSTAT + (tok * 6 + (cg - 6)) * 2) = make_float2(s1, s2);
    }
  } else if (cg < 18) {
    epi_act(q, rs, (u16*)(ws_ + W_SGA), 384, (cg - 12) * 64, tokb, false, lane);
  } else if (cg < 24) {
    const int h = cg - 18, sh = (h >> 1) * 2;
    head_norm(q, rs, p.q_norm, QSCALE, true, pos, ROPE, lane);
    if (!sample) {
      u16* QP = (u16*)(ws_ + W_QP);
#pragma unroll
      for (int np = 0; np < 4; ++np) {
        int tok = tokb + (np >> 1) * 128 + (np & 1) * 16, b = tok >> 13, t = tok & (SEQ - 1);
        long base = ((long)(b * 6 + h) * SEQ + perm_pos(t, sh)) * 64;
#pragma unroll
        for (int m = 0; m < 4; ++m) {
          uint2 o = {pk2(QV(m, np)[0], QV(m, np)[1]), pk2(QV(m, np)[2], QV(m, np)[3])};
          *(uint2*)(QP + base + m * 16 + fq * 4) = o;
        }
      }
    } else {
      float* QS = (float*)(ws_ + W_QS);
#pragma unroll
      for (int np = 0; np < 4; ++np) {
        int srow = tokb + (np >> 1) * 128 + (np & 1) * 16 - PROWS;
#pragma unroll
        for (int m = 0; m < 4; ++m)
          *(float4*)(QS + (long)srow * 384 + h * 64 + m * 16 + fq * 4) = make_float4(QV(m, np)[0], QV(m, np)[1], QV(m, np)[2], QV(m, np)[3]);
      }
    }
  } else if (cg < 36) {
    const bool isk = cg < 30;
    const int h = isk ? cg - 24 : cg - 30, g = h >> 1, jh = h & 1, sh = g * 2, kv = isk ? 0 : 1;
    const int W = 128 << sh;
    if (isk) {
      head_norm(q, rs, p.k_norm, 1.f, true, pos, ROPE, lane);
    } else {
#pragma unroll
      for (int np = 0; np < 4; ++np)
#pragma unroll
        for (int m = 0; m < 4; ++m)
#pragma unroll
          for (int j = 0; j < 4; ++j) QV(m, np)[j] *= rs[np];
    }
    if (!sample) {
      u16* KP = (u16*)(ws_ + (isk ? W_KP : W_VP));
      float* wout = out_ + (g == 0 ? O_W0P : (g == 1 ? O_W1P : O_W2P));
#pragma unroll
      for (int np = 0; np < 4; ++np) {
        int tok = tokb + (np >> 1) * 128 + (np & 1) * 16, b = tok >> 13, t = tok & (SEQ - 1);
        long base = ((long)(b * 6 + h) * SEQ + perm_pos(t, sh)) * 64;
#pragma unroll
        for (int m = 0; m < 4; ++m) {
          uint2 o = {pk2(QV(m, np)[0], QV(m, np)[1]), pk2(QV(m, np)[2], QV(m, np)[3])};
          *(uint2*)(KP + base + m * 16 + fq * 4) = o;
        }
        if (t >= SEQ - W) {
          long ob = ((((long)b * W + (t - (SEQ - W))) * 2 + kv) * 2 + jh) * 64;
#pragma unroll
          for (int m = 0; m < 4; ++m)
            *(float4*)(wout + ob + m * 16 + fq * 4) = make_float4(QV(m, np)[0], QV(m, np)[1], QV(m, np)[2], QV(m, np)[3]);
        }
      }
    } else {
      float* wout = out_ + (g == 0 ? O_W0S : (g == 1 ? O_W1S : O_W2S));
#pragma unroll
      for (int np = 0; np < 4; ++np) {
        int srow = tokb + (np >> 1) * 128 + (np & 1) * 16 - PROWS, b = srow >> 3, t = srow & 7;
        long ob = ((((long)b * W + (W - 8 + t)) * 2 + kv) * 2 + jh) * 64;
#pragma unroll
        for (int m = 0; m < 4; ++m)
          *(float4*)(wout + ob + m * 16 + fq * 4) = make_float4(QV(m, np)[0], QV(m, np)[1], QV(m, np)[2], QV(m, np)[3]);
      }
    }
  } else if (cg < 42) {
    epi_act(q, rs, (u16*)(ws_ + W_SGB), 384, (cg - 36) * 64, tokb, false, lane);
  } else if (cg < 46) {
    const int mh = cg - 42;
    head_norm(q, rs, p.mem_q_norm, QSCALE, false, pos, ROPE, lane);
    if (!sample) {
      u16* QC = (u16*)(ws_ + W_QC);
#pragma unroll
      for (int np = 0; np < 4; ++np) {
        long tok = tokb + (np >> 1) * 128 + (np & 1) * 16;
#pragma unroll
        for (int m = 0; m < 4; ++m) {
          uint2 o = {pk2(QV(m, np)[0], QV(m, np)[1]), pk2(QV(m, np)[2], QV(m, np)[3])};
          *(uint2*)(QC + tok * 256 + mh * 64 + m * 16 + fq * 4) = o;
        }
      }
    } else {
      float* QCS = (float*)(ws_ + W_QCS);
#pragma unroll
      for (int np = 0; np < 4; ++np) {
        int srow = tokb + (np >> 1) * 128 + (np & 1) * 16 - PROWS;
#pragma unroll
        for (int m = 0; m < 4; ++m)
          *(float4*)(QCS + (long)srow * 256 + mh * 64 + m * 16 + fq * 4) = make_float4(QV(m, np)[0], QV(m, np)[1], QV(m, np)[2], QV(m, np)[3]);
      }
    }
  } else if (cg < 50) {
    epi_act(q, rs, (u16*)(ws_ + W_SGC), 256, (cg - 46) * 64, tokb, false, lane);
  }
}

DEVI void memkv_group(char* ws_, float* out_, const Params& p, f32x4 (&q)[2][4][2], int cgm, int rowb, const int lane) {
  const int fq = lane >> 4;
  const float* MR = (const float*)(ws_ + W_RSTD) + ROWS;
  const float2* ROPE = (const float2*)(ws_ + W_ROPE);
  float* mout = out_ + O_MKV;
  float rs[4];
  int pos[4] = {0, 0, 0, 0};
#pragma unroll
  for (int np = 0; np < 4; ++np) rs[np] = MR[rowb + (np >> 1) * 128 + (np & 1) * 16];
  const bool isk = cgm < 4;
  const int mh = cgm & 3;
  if (isk) {
    head_norm(q, rs, p.mem_k_norm, 1.f, false, pos, ROPE, lane);
  } else {
#pragma unroll
    for (int np = 0; np < 4; ++np)
#pragma unroll
      for (int m = 0; m < 4; ++m)
#pragma unroll
        for (int j = 0; j < 4; ++j) QV(m, np)[j] *= rs[np];
  }
  u16* MKV = (u16*)(ws_ + (isk ? W_MK : W_MV));
#pragma unroll
  for (int np = 0; np < 4; ++np) {
    int row = rowb + (np >> 1) * 128 + (np & 1) * 16, b = row >> 8, mm = row & 255;
#pragma unroll
    for (int m = 0; m < 4; ++m) {
      uint2 o = {pk2(QV(m, np)[0], QV(m, np)[1]), pk2(QV(m, np)[2], QV(m, np)[3])};
      *(uint2*)(MKV + ((long)(b * 4 + mh) * 256 + mm) * 64 + m * 16 + fq * 4) = o;
      *(float4*)(mout + (((long)row * 2 + (isk ? 0 : 1)) * 4 + mh) * 64 + m * 16 + fq * 4) =
          make_float4(QV(m, np)[0], QV(m, np)[1], QV(m, np)[2], QV(m, np)[3]);
    }
  }
}

constexpr int P1_TILES = 68 * 13, P1_ALL = P1_TILES + 4;
DEVI void phase1_tile(const Params& p, char* lds, int tile) {
  unsigned long wsi_ = (unsigned long)p.ws; asm volatile("" : "+s"(wsi_)); char* ws_ = (char*)(GAS char*)wsi_;
  unsigned long outi_ = (unsigned long)p.out; asm volatile("" : "+s"(outi_)); float* out_ = (float*)(GAS float*)outi_;
  int tid_ = threadIdx.x; asm volatile("" : "+v"(tid_));
  const int tid = tid_, lane = tid & 63, wid = tid >> 6, wr = wid >> 2, wc = wid & 3, fr = lane & 15;
  f32x4 acc[2][2][4][2];
  if (tile < P1_TILES) {
    const int mt = tile / 13, nt = tile % 13;
    gemm256((const u16*)(ws_ + W_WINT) + (long)nt * 256 * 1024, (const u16*)(ws_ + W_XB) + (long)mt * 256 * 1024, acc, lds, tid);
    const int tokb = mt * 256 + wc * 32 + fr;
    __builtin_amdgcn_sched_barrier(0);
    phase1_group(ws_, out_, p, acc[0], nt * 4 + wr, tokb, mt >= 64, lane);
    __builtin_amdgcn_sched_barrier(0);
    phase1_group(ws_, out_, p, acc[1], nt * 4 + 2 + wr, tokb, mt >= 64, lane);
  } else {
    const int t2 = tile - P1_TILES, mt = t2 >> 1, nt = t2 & 1;
    gemm256((const u16*)(ws_ + W_WMEMT) + (long)nt * 256 * 1024, (const u16*)(ws_ + W_MEMB) + (long)mt * 256 * 1024, acc, lds, tid);
    const int rowb = mt * 256 + wc * 32 + fr;
    __builtin_amdgcn_sched_barrier(0);
    memkv_group(ws_, out_, p, acc[0], nt * 4 + wr, rowb, lane);
    __builtin_amdgcn_sched_barrier(0);
    memkv_group(ws_, out_, p, acc[1], nt * 4 + 2 + wr, rowb, lane);
  }
}

template <bool DIL>
DEVI void attn_task(const Params& p, char* lds, int task) {
  unsigned long wsi_ = (unsigned long)p.ws; asm volatile("" : "+s"(wsi_)); char* ws_ = (char*)(GAS char*)wsi_;
  int tid_ = threadIdx.x; asm volatile("" : "+v"(tid_));
  const int tid = tid_, lane = tid & 63, w = tid >> 6, fr = lane & 15, fq = lane >> 4;
  char* Kl = lds;
  char* Vl = lds + 256 * KSTR;
  int b, h, j, sh = 0;
  bool hasprev = true;
  const u16 *Kg, *Vg, *Qg;
  long qstride;
  int kprev0, kown0;
  if (DIL) {
    b = task / 384; h = (task >> 6) % 6; j = task & 63;
    sh = (h >> 1) * 2;
    hasprev = (j & ((64 >> sh) - 1)) != 0;
    Kg = (const u16*)(ws_ + W_KP) + (long)(b * 6 + h) * SEQ * 64;
    Vg = (const u16*)(ws_ + W_VP) + (long)(b * 6 + h) * SEQ * 64;
    Qg = (const u16*)(ws_ + W_QP) + ((long)(b * 6 + h) * SEQ + j * 128) * 64;
    qstride = 64;
    kown0 = j * 128 - 128;
    kprev0 = hasprev ? (j - 1) * 128 : j * 128;
  } else {
    b = task >> 7; h = (task >> 5) & 3; j = (task & 31) * 2;
    Kg = (const u16*)(ws_ + W_MK) + (long)(b * 4 + h) * 256 * 64;
    Vg = (const u16*)(ws_ + W_MV) + (long)(b * 4 + h) * 256 * 64;
    Qg = (const u16*)(ws_ + W_QC) + ((long)b * SEQ + j * 128) * 256 + h * 64;
    qstride = 256;
    kown0 = 0; kprev0 = 0;
  }
  const int sb = w;
  bf16x8 qf[2];
  uint2 gcv[4];
  {
    const u16* qrow = Qg + (long)(sb * 16 + fr) * qstride;
    qf[0] = *(const bf16x8*)(qrow + fq * 8);
    qf[1] = *(const bf16x8*)(qrow + 32 + fq * 8);
    if (!DIL) {
      const long row = (long)b * SEQ + j * 128 + sb * 16 + fr;
      const u16* SGC = (const u16*)(ws_ + W_SGC);
#pragma unroll
      for (int dt = 0; dt < 4; ++dt) gcv[dt] = *(const uint2*)(SGC + row * 256 + h * 64 + dt * 16 + fq * 4);
    }
  }
  __syncthreads();
#pragma unroll
  for (int i = 0; i < 4; ++i) {
    int c = tid + i * NT;
    int key = c >> 3, part = c & 7;
    int src = (key < 128 ? kprev0 : kown0) + key;
    uint4 kvv = *(const uint4*)(Kg + (long)src * 64 + part * 8);
    uint4 vvv = *(const uint4*)(Vg + (long)src * 64 + part * 8);
    *(uint4*)(Kl + key * KSTR + part * 16) = kvv;
    *(uint4*)(Vl + key * VSTR + part * 16) = vvv;
  }
  __syncthreads();
#pragma unroll 1
  for (int rq = 0; rq < (DIL ? 1 : 2); ++rq) {
    if (rq > 0) {
      j += 1;
      const u16* qrow = Qg + (long)(128 + sb * 16 + fr) * qstride;
      qf[0] = *(const bf16x8*)(qrow + fq * 8);
      qf[1] = *(const bf16x8*)(qrow + 32 + fq * 8);
      const long row = (long)b * SEQ + j * 128 + sb * 16 + fr;
      const u16* SGC = (const u16*)(ws_ + W_SGC);
#pragma unroll
      for (int dt = 0; dt < 4; ++dt) gcv[dt] = *(const uint2*)(SGC + row * 256 + h * 64 + dt * 16 + fq * 4);
    }
    f32x4 s[16];
#pragma unroll
    for (int kt = 0; kt < 16; ++kt) {
      s[kt] = (f32x4){0.f, 0.f, 0.f, 0.f};
#pragma unroll
      for (int ks = 0; ks < 2; ++ks) {
        bf16x8 a = *(const bf16x8*)(Kl + (kt * 16 + fr) * KSTR + ks * 64 + fq * 16);
        s[kt] = mfma16(a, qf[ks], s[kt]);
      }
      if ((kt & 3) == 3) __builtin_amdgcn_sched_barrier(0);
    }
    const int qo = sb * 16 + fr;
    float mx = -3.0e38f;
#pragma unroll
    for (int kt = 0; kt < 16; ++kt)
#pragma unroll
      for (int jj = 0; jj < 4; ++jj) {
        if (DIL) {
          int ko = kt * 16 + fq * 4 + jj;
          bool valid = (ko < 128) ? (hasprev && ko >= qo) : (ko - 128 <= qo);
          if (!valid) s[kt][jj] = NEGV;
        }
        mx = fmaxf(mx, s[kt][jj]);
      }
    mx = fmaxf(mx, __shfl_xor(mx, 16));
    mx = fmaxf(mx, __shfl_xor(mx, 32));
    float l = 0.f;
#pragma unroll
    for (int kt = 0; kt < 16; ++kt)
#pragma unroll
      for (int jj = 0; jj < 4; ++jj) {
        float e = __expf(s[kt][jj] - mx);
        s[kt][jj] = e;
        l += e;
      }
    l += __shfl_xor(l, 16);
    l += __shfl_xor(l, 32);
    const float il = 1.f / l;
    f32x4 o[4];
#pragma unroll
    for (int dt = 0; dt < 4; ++dt) o[dt] = (f32x4){0.f, 0.f, 0.f, 0.f};
    const char* vbase = Vl + (fq * 4 + (fr >> 2)) * VSTR + (fr & 3) * 8;
#pragma unroll
    for (int kk = 0; kk < 8; ++kk) {
      union { bf16x8 v; unsigned u[4]; } pf;
      pf.u[0] = pk2(s[2 * kk][0] * il, s[2 * kk][1] * il);
      pf.u[1] = pk2(s[2 * kk][2] * il, s[2 * kk][3] * il);
      pf.u[2] = pk2(s[2 * kk + 1][0] * il, s[2 * kk + 1][1] * il);
      pf.u[3] = pk2(s[2 * kk + 1][2] * il, s[2 * kk + 1][3] * il);
#pragma unroll
      for (int dt = 0; dt < 4; ++dt) {
        s16x4 lo = tr_read(vbase + (kk * 32) * VSTR + dt * 32);
        s16x4 hi = tr_read(vbase + (kk * 32 + 16) * VSTR + dt * 32);
        o[dt] = mfma16(cat8(lo, hi), pf.v, o[dt]);
      }
      __builtin_amdgcn_sched_barrier(0);
    }
    if (DIL) {
      int pp = j * 128 + qo;
      int t = ((pp & ((SEQ >> sh) - 1)) << sh) + (pp >> (13 - sh));
      long row = (long)b * SEQ + t;
      u16* O = (u16*)(ws_ + W_O);
#pragma unroll
      for (int dt = 0; dt < 4; ++dt) {
        uint2 ov = {pk2(o[dt][0], o[dt][1]), pk2(o[dt][2], o[dt][3])};
        *(uint2*)(O + row * 384 + h * 64 + dt * 16 + fq * 4) = ov;
      }
      if (fq == 0) ((float*)(ws_ + W_LSE))[row * 6 + h] = mx + __logf(l);
    } else {
      long row = (long)b * SEQ + j * 128 + qo;
      u16* MIX = (u16*)(ws_ + W_MIX);
#pragma unroll
      for (int dt = 0; dt < 4; ++dt) {
        uint2 ov = {pk2(o[dt][0] * bflo(gcv[dt].x), o[dt][1] * bfhi(gcv[dt].x)), pk2(o[dt][2] * bflo(gcv[dt].y), o[dt][3] * bfhi(gcv[dt].y))};
        *(uint2*)(MIX + row * 1024 + 768 + h * 64 + dt * 16 + fq * 4) = ov;
      }
    }
  }
}

DEVI void gmlp_task(const Params& p, char* lds, int task) {
  unsigned long wsi_ = (unsigned long)p.ws; asm volatile("" : "+s"(wsi_)); char* ws_ = (char*)(GAS char*)wsi_;
  int tid_ = threadIdx.x; asm volatile("" : "+v"(tid_));
  const int tid = tid_, lane = tid & 63, w = tid >> 6, fr = lane & 15, fq = lane >> 4;
  const int chunk = task / 6, g = task % 6;
  float* mu = (float*)lds;
  float* rstd = mu + 128;
  char* Vl = lds + 1024;
  const float* VSTAT = (const float*)(ws_ + W_VSTAT);
  const u16* GV = (const u16*)(ws_ + W_GV);
  const u16* WSB = (const u16*)(ws_ + W_WSB) + (long)g * 128 * 128;
  const int t = w * 16 + fr;
  uint2 wf[4][2], uvp[4], gvp[4];
#pragma unroll
  for (int ks = 0; ks < 4; ++ks) {
    wf[ks][0] = *(const uint2*)(WSB + (long)t * 128 + ks * 32 + fq * 4);
    wf[ks][1] = *(const uint2*)(WSB + (long)t * 128 + ks * 32 + 16 + fq * 4);
  }
  {
    const long row = (long)chunk * 128 + t;
#pragma unroll
    for (int m = 0; m < 4; ++m) {
      uvp[m] = *(const uint2*)((const u16*)(ws_ + W_U) + row * 384 + g * 64 + m * 16 + fq * 4);
      gvp[m] = *(const uint2*)((const u16*)(ws_ + W_SGA) + row * 384 + g * 64 + m * 16 + fq * 4);
    }
  }
  const float bs = p.b_s[g * 128 + t];
  __syncthreads();
  if (tid < 128) {
    long row = (long)chunk * 128 + tid;
    float s1 = 0.f, s2 = 0.f;
#pragma unroll
    for (int i = 0; i < 6; ++i) { float2 v = *(const float2*)(VSTAT + (row * 6 + i) * 2); s1 += v.x; s2 += v.y; }
    float m = s1 * (1.f / 384.f);
    float var = fmaxf(s2 * (1.f / 384.f) - m * m, 0.f);
    mu[tid] = m;
    rstd[tid] = rsqrtf(var + EPS);
  }
  __syncthreads();
#pragma unroll
  for (int i = 0; i < 2; ++i) {
    int c = tid + i * NT;
    int s = c >> 3, part = c & 7;
    int col = g * 64 + part * 8;
    uint4 v = *(const uint4*)(GV + ((long)chunk * 128 + s) * 384 + col);
    float4 g0 = *(const float4*)(p.ln_g + col), g1 = *(const float4*)(p.ln_g + col + 4);
    float4 b0 = *(const float4*)(p.ln_b + col), b1 = *(const float4*)(p.ln_b + col + 4);
    float m = mu[s], r = rstd[s];
    unsigned o0 = pk2((bflo(v.x) - m) * r * g0.x + b0.x, (bfhi(v.x) - m) * r * g0.y + b0.y);
    unsigned o1 = pk2((bflo(v.y) - m) * r * g0.z + b0.z, (bfhi(v.y) - m) * r * g0.w + b0.w);
    unsigned o2 = pk2((bflo(v.z) - m) * r * g1.x + b1.x, (bfhi(v.z) - m) * r * g1.y + b1.y);
    unsigned o3 = pk2((bflo(v.w) - m) * r * g1.z + b1.z, (bfhi(v.w) - m) * r * g1.w + b1.w);
    *(uint4*)(Vl + s * VSTR + part * 16) = make_uint4(o0, o1, o2, o3);
  }
  __syncthreads();
  f32x4 acc[4];
#pragma unroll
  for (int m = 0; m < 4; ++m) acc[m] = (f32x4){0.f, 0.f, 0.f, 0.f};
  const char* vbase = Vl + (fq * 4 + (fr >> 2)) * VSTR + (fr & 3) * 8;
#pragma unroll
  for (int ks = 0; ks < 4; ++ks) {
    if (ks * 32 <= w * 16 + 15) {
      union { bf16x8 v; uint2 u[2]; } bw;
      bw.u[0] = wf[ks][0];
      bw.u[1] = wf[ks][1];
#pragma unroll
      for (int m = 0; m < 4; ++m) {
        s16x4 lo = tr_read(vbase + (ks * 32) * VSTR + m * 32);
        s16x4 hi = tr_read(vbase + (ks * 32 + 16) * VSTR + m * 32);
        acc[m] = mfma16(cat8(lo, hi), bw.v, acc[m]);
      }
    }
  }
  u16* MIX = (u16*)(ws_ + W_MIX);
  {
    long row = (long)chunk * 128 + t;
#pragma unroll
    for (int m = 0; m < 4; ++m) {
      int c = g * 64 + m * 16 + fq * 4;
      uint2 uv = uvp[m];
      uint2 gv = gvp[m];
      float r0 = (acc[m][0] + bs) * bflo(uv.x) * bflo(gv.x);
      float r1 = (acc[m][1] + bs) * bfhi(uv.x) * bfhi(gv.x);
      float r2 = (acc[m][2] + bs) * bflo(uv.y) * bflo(gv.y);
      float r3 = (acc[m][3] + bs) * bfhi(uv.y) * bfhi(gv.y);
      *(uint2*)(MIX + row * 1024 + c) = make_uint2(pk2(r0, r1), pk2(r2, r3));
    }
  }
}

DEVI void step_attn_task(const Params& p, char* lds, int task) {
  unsigned long wsi_ = (unsigned long)p.ws; asm volatile("" : "+s"(wsi_)); char* ws_ = (char*)(GAS char*)wsi_;
  unsigned long outi_ = (unsigned long)p.out; asm volatile("" : "+s"(outi_)); float* out_ = (float*)(GAS float*)outi_;
  int tid_ = threadIdx.x; asm volatile("" : "+v"(tid_));
  const int tid = tid_, lane = tid & 63, w = tid >> 6, part = lane & 15, ks = lane >> 4;
  const int b = task / 10, hh = task % 10, t = w;
  const int srow = b * 8 + t;
  float* sc = (float*)lds + w * 264;
  const bool dil = hh < 6;
  int nkeys, g = 0, jh = 0, L = 0, sh = 0;
  const float *stbuf = nullptr, *nbuf = nullptr, *q;
  const float* const cm = p.cache_mem;
  if (dil) {
    g = hh >> 1; jh = hh & 1; sh = g * 2; L = 128 << sh; nkeys = 129;
    const float* const a0 = p.st0; const float* const a1 = p.st1; const float* const a2 = p.st2;
    stbuf = g == 0 ? a0 : (g == 1 ? a1 : a2);
    nbuf = out_ + (g == 0 ? O_W0S : (g == 1 ? O_W1S : O_W2S));
    q = (const float*)(ws_ + W_QS) + (long)srow * 384 + hh * 64;
  } else {
    nkeys = 256;
    q = (const float*)(ws_ + W_QCS) + (long)srow * 256 + (hh - 6) * 64;
  }
  auto kvptr = [&](int m, int kv) __attribute__((always_inline)) -> const float* {
    if (dil) {
      int idx = L + t - (m << sh);
      if (idx < L) return stbuf + ((((long)b * L + idx) * 2 + kv) * 2 + jh) * 64;
      return nbuf + ((((long)b * L + (idx - 8)) * 2 + kv) * 2 + jh) * 64;
    } else {
      return cm + ((((long)b * 256 + m) * 2 + kv) * 4 + (hh - 6)) * 64;
    }
  };
  __syncthreads();
  const float4 q4 = *(const float4*)(q + part * 4);
  const int nit = (nkeys + 3) >> 2;
  constexpr int SB = 17;
  for (int it0 = 0; it0 < nit; it0 += SB) {
    float4 kb[SB];
#pragma unroll
    for (int u = 0; u < SB; ++u) {
      int m = min((it0 + u) * 4 + ks, nkeys - 1);
      kb[u] = *(const float4*)(kvptr(m, 0) + part * 4);
    }
#pragma unroll
    for (int u = 0; u < SB; ++u) {
      int m = (it0 + u) * 4 + ks;
      float dot = red16(q4.x * kb[u].x + q4.y * kb[u].y + q4.z * kb[u].z + q4.w * kb[u].w);
      if (part == 0 && m < nkeys) sc[m] = dot;
    }
  }
  __syncthreads();
  float mx = -3.0e38f;
  for (int m = lane; m < nkeys; m += 64) mx = fmaxf(mx, sc[m]);
  mx = wave_max(mx);
  float l = 0.f;
  for (int m = lane; m < nkeys; m += 64) l += __expf(sc[m] - mx);
  l = wave_sum(l);
  const float il = 1.f / l;
  __syncthreads();
  for (int m = lane; m < nkeys; m += 64) sc[m] = __expf(sc[m] - mx) * il;
  __syncthreads();
  float4 o4 = make_float4(0.f, 0.f, 0.f, 0.f);
  for (int it0 = 0; it0 < nit; it0 += SB) {
    float4 vb[SB];
    float pm[SB];
#pragma unroll
    for (int u = 0; u < SB; ++u) {
      int m = (it0 + u) * 4 + ks;
      int mc = min(m, nkeys - 1);
      vb[u] = *(const float4*)(kvptr(mc, 1) + part * 4);
      pm[u] = (m < nkeys) ? sc[mc] : 0.f;
    }
#pragma unroll
    for (int u = 0; u < SB; ++u) {
      o4.x += pm[u] * vb[u].x; o4.y += pm[u] * vb[u].y; o4.z += pm[u] * vb[u].z; o4.w += pm[u] * vb[u].w;
    }
  }
  o4.x += __shfl_xor(o4.x, 16); o4.y += __shfl_xor(o4.y, 16); o4.z += __shfl_xor(o4.z, 16); o4.w += __shfl_xor(o4.w, 16);
  o4.x += __shfl_xor(o4.x, 32); o4.y += __shfl_xor(o4.y, 32); o4.z += __shfl_xor(o4.z, 32); o4.w += __shfl_xor(o4.w, 32);
  const long row = PROWS + srow;
  if (ks == 0) {
    if (dil) {
      u16* O = (u16*)(ws_ + W_O);
      *(uint2*)(O + row * 384 + hh * 64 + part * 4) = make_uint2(pk2(o4.x, o4.y), pk2(o4.z, o4.w));
      if (part == 0) ((float*)(ws_ + W_LSE))[row * 6 + hh] = mx + __logf(l);
    } else {
      const int mh = hh - 6;
      const u16* SGC = (const u16*)(ws_ + W_SGC);
      u16* MIX = (u16*)(ws_ + W_MIX);
      uint2 gcv = *(const uint2*)(SGC + row * 256 + mh * 64 + part * 4);
      *(uint2*)(MIX + row * 1024 + 768 + mh * 64 + part * 4) =
          make_uint2(pk2(o4.x * bflo(gcv.x), o4.y * bfhi(gcv.x)), pk2(o4.z * bflo(gcv.y), o4.w * bfhi(gcv.y)));
    }
  }
}

template <bool MEM>
DEVI void shared_attn_task(const Params& p, char* lds, int b, int hh) {
  constexpr int NU = MEM ? 8 : 5, RW = MEM ? 32 : 17, NR = MEM ? 256 : 136, SCS = 264;
  unsigned long wsi_ = (unsigned long)p.ws; asm volatile("" : "+s"(wsi_)); char* ws_ = (char*)(GAS char*)wsi_;
  unsigned long outi_ = (unsigned long)p.out; asm volatile("" : "+s"(outi_)); float* out_ = (float*)(GAS float*)outi_;
  int tid_ = threadIdx.x; asm volatile("" : "+v"(tid_));
  const int tid = tid_, lane = tid & 63, w = tid >> 6, part = lane & 15, ks = lane >> 4;
  float* sc = (float*)lds;
  float* red = (float*)lds + 8 * SCS;
  const int mh = hh - 6, jh = hh & 1;
  const float* const cm = p.cache_mem;
  const float* const s0 = p.st0;
  const float* const nb0 = out_ + O_W0S;
  auto rowptr = [&](int r, int kv) __attribute__((always_inline)) -> const float* {
    if (MEM) return cm + ((((long)b * 256 + r) * 2 + kv) * 4 + mh) * 64;
    if (r < 128) return s0 + ((((long)b * 128 + r) * 2 + kv) * 2 + jh) * 64;
    return nb0 + ((((long)b * 128 + (r - 8)) * 2 + kv) * 2 + jh) * 64;
  };
  float4 kb[NU], vb[NU];
#pragma unroll
  for (int u = 0; u < NU; ++u) {
    int r = min(w * RW + u * 4 + ks, NR - 1);
    kb[u] = *(const float4*)(rowptr(r, 0) + part * 4);
    vb[u] = *(const float4*)(rowptr(r, 1) + part * 4);
  }
  float4 q4[8];
#pragma unroll
  for (int t = 0; t < 8; ++t) {
    const float* q = MEM ? (const float*)(ws_ + W_QCS) + (long)(b * 8 + t) * 256 + mh * 64 : (const float*)(ws_ + W_QS) + (long)(b * 8 + t) * 384 + hh * 64;
    q4[t] = *(const float4*)(q + part * 4);
  }
  __syncthreads();
#pragma unroll
  for (int u = 0; u < NU; ++u) {
    float d[8];
#pragma unroll
    for (int t = 0; t < 8; ++t) {
      float x = q4[t].x * kb[u].x + q4[t].y * kb[u].y + q4[t].z * kb[u].z + q4[t].w * kb[u].w;
      d[t] = red16(x);
    }
    const int pt = part & 7;
    float v = d[0];
    v = pt == 1 ? d[1] : v; v = pt == 2 ? d[2] : v; v = pt == 3 ? d[3] : v; v = pt == 4 ? d[4] : v;
    v = pt == 5 ? d[5] : v; v = pt == 6 ? d[6] : v; v = pt == 7 ? d[7] : v;
    const int rl = u * 4 + ks, r = w * RW + rl;
    if (part < 8 && rl < RW && r < NR) {
      if (!MEM && !(r >= part && r <= part + 128)) v = NEGV;
      sc[part * SCS + r] = v;
    }
  }
  __syncthreads();
  {
    const int t = w;
    float mx = -3.0e38f;
    for (int m = lane; m < NR; m += 64) mx = fmaxf(mx, sc[t * SCS + m]);
    mx = wave_max(mx);
    float l = 0.f;
    for (int m = lane; m < NR; m += 64) l += __expf(sc[t * SCS + m] - mx);
    l = wave_sum(l);
    const float il = 1.f / l;
    for (int m = lane; m < NR; m += 64) sc[t * SCS + m] = __expf(sc[t * SCS + m] - mx) * il;
    if (!MEM && lane == 0) ((float*)(ws_ + W_LSE))[(long)(PROWS + b * 8 + t) * 6 + hh] = mx + __logf(l);
  }
  __syncthreads();
  float4 o[8];
#pragma unroll
  for (int t = 0; t < 8; ++t) o[t] = make_float4(0.f, 0.f, 0.f, 0.f);
#pragma unroll
  for (int u = 0; u < NU; ++u) {
    const int rl = u * 4 + ks, r = w * RW + rl;
    const bool valid = rl < RW && r < NR;
    const int rc = min(r, NR - 1);
#pragma unroll
    for (int t = 0; t < 8; ++t) {
      float pm = valid ? sc[t * SCS + rc] : 0.f;
      o[t].x += pm * vb[u].x; o[t].y += pm * vb[u].y; o[t].z += pm * vb[u].z; o[t].w += pm * vb[u].w;
    }
  }
#pragma unroll
  for (int t = 0; t < 8; ++t) *(float4*)(red + ((w * 4 + ks) * 8 + t) * 64 + part * 4) = o[t];
  __syncthreads();
  {
    const int t = tid >> 6, d = tid & 63;
    float acc = 0.f;
#pragma unroll
    for (int ww = 0; ww < 32; ++ww) acc += red[(ww * 8 + t) * 64 + d];
    const long row = PROWS + b * 8 + t;
    if (MEM) {
      const u16* SGC = (const u16*)(ws_ + W_SGC);
      ((u16*)(ws_ + W_MIX))[row * 1024 + 768 + mh * 64 + d] = f2bf(acc * bf2f(SGC[row * 256 + mh * 64 + d]));
    } else {
      ((u16*)(ws_ + W_O))[row * 384 + hh * 64 + d] = f2bf(acc);
    }
  }
}

DEVI void sample_gmlp_task(const Params& p, char* lds, int b) {
  unsigned long wsi_ = (unsigned long)p.ws; asm volatile("" : "+s"(wsi_)); char* ws_ = (char*)(GAS char*)wsi_;
  unsigned long outi_ = (unsigned long)p.out; asm volatile("" : "+s"(outi_)); float* out_ = (float*)(GAS float*)outi_;
  int tid_ = threadIdx.x; asm volatile("" : "+v"(tid_)); const int tid = tid_;
  float* mu = (float*)lds;
  float* rstd = mu + 8;
  const float* VSTAT = (const float*)(ws_ + W_VSTAT);
  const u16* GV = (const u16*)(ws_ + W_GV);
  __syncthreads();
  if (tid < 8) {
    long row = PROWS + b * 8 + tid;
    float s1 = 0.f, s2 = 0.f;
    for (int i = 0; i < 6; ++i) { float2 v = *(const float2*)(VSTAT + (row * 6 + i) * 2); s1 += v.x; s2 += v.y; }
    float m = s1 * (1.f / 384.f);
    float var = fmaxf(s2 * (1.f / 384.f) - m * m, 0.f);
    mu[tid] = m; rstd[tid] = rsqrtf(var + EPS);
  }
  __syncthreads();
  const u16* U = (const u16*)(ws_ + W_U);
  const u16* SGA = (const u16*)(ws_ + W_SGA);
  u16* MIX = (u16*)(ws_ + W_MIX);
  float* gvout = out_ + O_GV;
  if (tid < 384) {
    const int c = tid, g = c >> 6;
    float lg = p.ln_g[c], lb = p.ln_b[c];
    float v[8];
#pragma unroll
    for (int s = 0; s < 8; ++s) {
      long row = PROWS + b * 8 + s;
      v[s] = (bf2f(GV[row * 384 + c]) - mu[s]) * rstd[s] * lg + lb;
      gvout[((long)b * 8 + s) * 384 + c] = v[s];
    }
#pragma unroll
    for (int t = 0; t < 8; ++t) {
      float sacc = p.b_s[g * 128 + t];
#pragma unroll
      for (int s = 0; s < 8; ++s)
        if (s <= t) sacc += p.w_s[((long)g * 128 + t) * 128 + s] * v[s];
      long row = PROWS + b * 8 + t;
      float r = sacc * bf2f(U[row * 384 + c]) * bf2f(SGA[row * 384 + c]);
      MIX[row * 1024 + c] = f2bf(r);
    }
  }
}

constexpr int NCOPY = 128 * (1 + 4 + 16);
DEVI void do_copy(const Params& p, int task) {
  const float* const a0 = p.st0; const float* const a1 = p.st1; const float* const a2 = p.st2; float* const po = p.out;
  int g, b, c, L, nch;
  const float* src; float* dst;
  if (task < 2048) { g = 2; b = task >> 4; c = task & 15; L = 2048; nch = 16; src = a2; dst = po + O_W2S; }
  else if (task < 2560) { g = 1; b = (task - 2048) >> 2; c = (task - 2048) & 3; L = 512; nch = 4; src = a1; dst = po + O_W1S; }
  else { g = 0; b = task - 2560; c = 0; L = 128; nch = 1; src = a0; dst = po + O_W0S; }
  (void)g;
  const f32x4* sp = (const f32x4*)src + ((long)b * L + 8) * 64 + (long)c * 8192 + threadIdx.x;
  f32x4* dp = (f32x4*)dst + (long)b * L * 64 + (long)c * 8192 + threadIdx.x;
  const bool last = (c == nch - 1);
  f32x4 v[16];
#pragma unroll
  for (int u = 0; u < 15; ++u) v[u] = __builtin_nontemporal_load(sp + u * 512);
  if (!last) v[15] = __builtin_nontemporal_load(sp + 15 * 512);
#pragma unroll
  for (int u = 0; u < 15; ++u) __builtin_nontemporal_store(v[u], dp + u * 512);
  if (!last) __builtin_nontemporal_store(v[15], dp + 15 * 512);
}
DEVI void copier_loop(const Params& p, char* lds, unsigned* ctl, int done_idx, unsigned done_target) {
  volatile unsigned* slot = (volatile unsigned*)lds;
  for (;;) {
    __syncthreads();
    if (threadIdx.x == 0) {
      unsigned t = NCOPY;
      if (done_target == 0u || xb_ld(&ctl[done_idx]) < done_target) t = xb_add(&ctl[CTL_COPY_HEAD], 1u);
      *slot = t;
    }
    __syncthreads();
    const unsigned t = *slot;
    if (t >= (unsigned)NCOPY) break;
    do_copy(p, (int)t);
  }
}

DEVI void phase3(const Params& p) {
  const int total = ROWS * 96;
  const u16* O = (const u16*)(p.ws + W_O);
  const u16* SGB = (const u16*)(p.ws + W_SGB);
  const float* LSE = (const float*)(p.ws + W_LSE);
  u16* MIX = (u16*)(p.ws + W_MIX);
  const int stride = gridDim.x * NT;
  for (int idx0 = blockIdx.x * NT + threadIdx.x; idx0 < total; idx0 += 4 * stride) {
    float l0[4], l1[4], l2[4];
    uint2 ov[4], gv[4];
    int rowv[4], cv[4];
#pragma unroll
    for (int q = 0; q < 4; ++q) {
      const int idx = min(idx0 + q * stride, total - 1);
      const int row = idx / 96, c = (idx - row * 96) * 4, jh = (c >> 6) & 1;
      rowv[q] = row; cv[q] = c;
      l0[q] = LSE[(long)row * 6 + jh]; l1[q] = LSE[(long)row * 6 + 2 + jh]; l2[q] = LSE[(long)row * 6 + 4 + jh];
      ov[q] = *(const uint2*)(O + (long)row * 384 + c);
      gv[q] = *(const uint2*)(SGB + (long)row * 384 + c);
    }
#pragma unroll
    for (int q = 0; q < 4; ++q) {
      if (idx0 + q * stride < total) {
        const int g = cv[q] >> 7;
        float mx = fmaxf(l0[q], fmaxf(l1[q], l2[q]));
        float e0 = __expf(l0[q] - mx), e1 = __expf(l1[q] - mx), e2 = __expf(l2[q] - mx);
        float wgt = (g == 0 ? e0 : (g == 1 ? e1 : e2)) / (e0 + e1 + e2);
        float r0 = bflo(ov[q].x) * wgt * bflo(gv[q].x), r1 = bfhi(ov[q].x) * wgt * bfhi(gv[q].x);
        float r2 = bflo(ov[q].y) * wgt * bflo(gv[q].y), r3 = bfhi(ov[q].y) * wgt * bfhi(gv[q].y);
        *(uint2*)(MIX + (long)rowv[q] * 1024 + 384 + cv[q]) = make_uint2(pk2(r0, r1), pk2(r2, r3));
      }
    }
  }
}

DEVI void phase4_tile(const Params& p, char* lds, int tile) {
  unsigned long wsi_ = (unsigned long)p.ws; asm volatile("" : "+s"(wsi_)); char* ws_ = (char*)(GAS char*)wsi_;
  unsigned long outi_ = (unsigned long)p.out; asm volatile("" : "+s"(outi_)); float* out_ = (float*)(GAS float*)outi_;
  int tid_ = threadIdx.x; asm volatile("" : "+v"(tid_));
  const int tid = tid_, lane = tid & 63, wid = tid >> 6, wr = wid >> 2, wc = wid & 3, fr = lane & 15, fq = lane >> 4;
  const int mt = tile >> 2, nt = tile & 3;
  f32x4 acc[2][2][4][2];
  gemm256((const u16*)(ws_ + W_WOUTT) + (long)nt * 256 * 1024, (const u16*)(ws_ + W_MIX) + (long)mt * 256 * 1024, acc, lds, tid);
  const float* const xp_ = p.x_prompt; const float* const xs_ = p.x_sample;
#pragma unroll
  for (int bj = 0; bj < 2; ++bj)
#pragma unroll
    for (int n = 0; n < 2; ++n) {
      long tok = mt * 256 + bj * 128 + wc * 32 + n * 16 + fr;
      const float* xr = tok < PROWS ? xp_ + tok * 1024 : xs_ + (tok - PROWS) * 1024;
      float* yr = tok < PROWS ? out_ + O_YP + tok * 1024 : out_ + O_YS + (tok - PROWS) * 1024;
#pragma unroll
      for (int ai = 0; ai < 2; ++ai)
#pragma unroll
        for (int m = 0; m < 4; ++m) {
          int col = nt * 256 + ai * 128 + wr * 64 + m * 16 + fq * 4;
          float4 xv = *(const float4*)(xr + col);
          f32x4 a = acc[ai][bj][m][n];
          *(float4*)(yr + col) = make_float4(xv.x + a[0], xv.y + a[1], xv.z + a[2], xv.w + a[3]);
        }
    }
}

constexpr int P1_GEMM_BLOCKS = 224;
constexpr int P4_GEMM_BLOCKS = 136;
__global__ void __launch_bounds__(NT) fwd_kernel(Params p) {
  extern __shared__ __attribute__((aligned(16))) char lds[];
  __shared__ uint4 xb_words;
  const int G = gridDim.x;
  unsigned* ctl = (unsigned*)(p.ws + W_CTL);
  if (threadIdx.x == 0) xb_words = make_uint4(0u, 0u, 0u, 0u);
  __syncthreads();
  XcdBarrier xb = xcd_barrier_post(ctl, (volatile LAS unsigned*)&xb_words);
  if (p.phase_hi == 99) cg::this_grid().sync();
  phase0(p);
  xcd_barrier(xb);
  {
    const int gb = G > P1_GEMM_BLOCKS ? P1_GEMM_BLOCKS : G;
    if ((int)blockIdx.x < gb) {
      int t_beg = blockIdx.x, t_end = P1_ALL, t_step = gb;
      if ((gb & 7) == 0) {
        const int x = blockIdx.x & 7;
        t_beg = ((P1_ALL * x) >> 3) + (blockIdx.x >> 3); t_end = (P1_ALL * (x + 1)) >> 3; t_step = gb >> 3;
      }
      for (int tile = t_beg; tile < t_end; tile += t_step) {
        phase1_tile(p, lds, tile);
        if (threadIdx.x == 0) xb_add(&ctl[CTL_P1_DONE], 1u);
      }
    } else {
      copier_loop(p, lds, ctl, CTL_P1_DONE, (unsigned)P1_ALL);
    }
  }
  xcd_barrier(xb);
  {
    constexpr int T0 = 768, T1 = T0 + 256, T2 = T1 + 768, T3 = T2 + 1280, T4 = T3 + 128;
    const int nk = (T4 + G - 1) / G;
    const int rot = (blockIdx.x >> 3) % nk;
    for (int kk = 0; kk < nk; ++kk) {
      int kx = kk + rot; if (kx >= nk) kx -= nk;
      const int task = blockIdx.x + kx * G;
      if (task >= T4) continue;
      if (task < T0) attn_task<true>(p, lds, task);
      else if (task < T1) attn_task<false>(p, lds, task - T0);
      else if (task < T2) gmlp_task(p, lds, task - T1);
      else if (task < T3) {
        const int st = task - T2, sb = st / 10, shh = st % 10;
        if (shh < 2) shared_attn_task<false>(p, lds, sb, shh);
        else if (shh >= 6) shared_attn_task<true>(p, lds, sb, shh);
        else step_attn_task(p, lds, st);
      }
      else sample_gmlp_task(p, lds, task - T3);
    }
  }
  xcd_barrier(xb);
  phase3(p);
  xcd_barrier(xb);
  {
    __syncthreads();
    const int gb = G > P4_GEMM_BLOCKS ? P4_GEMM_BLOCKS : G;
    if ((int)blockIdx.x < gb) {
      int t_beg = blockIdx.x, t_end = 272, t_step = gb;
      if ((gb & 7) == 0) {
        const int x = blockIdx.x & 7;
        t_beg = ((272 * x) >> 3) + (blockIdx.x >> 3); t_end = (272 * (x + 1)) >> 3; t_step = gb >> 3;
      }
      for (int tile = t_beg; tile < t_end; tile += t_step) {
        phase4_tile(p, lds, tile);
        if (threadIdx.x == 0) xb_add(&ctl[CTL_P4_DONE], 1u);
      }
    } else {
      copier_loop(p, lds, ctl, CTL_P4_DONE, 68u * 4u);
    }
    copier_loop(p, lds, ctl, 0, 0u);
  }
}

extern "C" void kernel_launch(void* const* d_in, const int* in_sizes, int n_in, void* d_out, int out_size, void* d_ws, size_t ws_size,
                              hipStream_t stream) {
  static int grid_blocks = 0;
  if (!grid_blocks) {
    int dev = 0, cus = 0, per_cu = 0;
    (void)hipGetDevice(&dev);
    (void)hipDeviceGetAttribute(&cus, hipDeviceAttributeMultiprocessorCount, dev);
    (void)hipFuncSetAttribute((const void*)fwd_kernel, hipFuncAttributeMaxDynamicSharedMemorySize, LDS_BYTES);
    (void)hipOccupancyMaxActiveBlocksPerMultiprocessor(&per_cu, (const void*)fwd_kernel, NT, LDS_BYTES);
    if (per_cu < 1) { fprintf(stderr, "occupancy query reports %d blocks/CU\n", per_cu); per_cu = 1; }
    if (per_cu > 1) per_cu = 1;
    grid_blocks = cus * per_cu;
    if (ws_size < W_END) fprintf(stderr, "workspace too small: %zu < %zu\n", ws_size, (size_t)W_END);
  }
  Params p{};
  p.x_prompt = (const float*)d_in[0]; p.x_sample = (const float*)d_in[1];
  p.st0 = (const float*)d_in[2]; p.st1 = (const float*)d_in[3]; p.st2 = (const float*)d_in[4];
  p.cache_mem = (const float*)d_in[5]; p.mem_prompt = (const float*)d_in[6]; p.norm_gain = (const float*)d_in[7];
  p.w_in = (const float*)d_in[8]; p.ln_g = (const float*)d_in[9]; p.ln_b = (const float*)d_in[10];
  p.w_s = (const float*)d_in[11]; p.b_s = (const float*)d_in[12]; p.q_norm = (const float*)d_in[13];
  p.k_norm = (const float*)d_in[14]; p.mem_norm = (const float*)d_in[15]; p.w_mem_kv = (const float*)d_in[16];
  p.mem_q_norm = (const float*)d_in[17]; p.mem_k_norm = (const float*)d_in[18]; p.w_out = (const float*)d_in[19];
  p.out = (float*)d_out; p.ws = (char*)d_ws;
  p.phase_lo = 0; p.phase_hi = 5;
  (void)hipMemsetAsync((char*)d_ws + W_CTL, 0, CTL_BYTES, stream);
  void* args[] = {&p};
  hipError_t e = hipLaunchCooperativeKernel((const void*)fwd_kernel, dim3(grid_blocks), dim3(NT), args, LDS_BYTES, stream);
  if (e != hipSuccess) fprintf(stderr, "cooperative launch failed: %s (grid %d)\n", hipGetErrorString(e), grid_blocks);
}
```

```cpp
#include <hip/hip_runtime.h>
#include <hip/hip_bf16.h>
#include <hip/hip_cooperative_groups.h>
#include <cstdio>
namespace cg = cooperative_groups;

typedef __attribute__((ext_vector_type(8))) short bf16x8;
typedef __attribute__((ext_vector_type(4))) short s16x4;
typedef __attribute__((ext_vector_type(4))) float f32x4;
typedef unsigned short u16;
#define DEVI __device__ __forceinline__
#define LAS __attribute__((address_space(3)))
#define GAS __attribute__((address_space(1)))
#define NT 512

constexpr int PROWS = 16384, SROWS = 1024, ROWS = 17408, SEQ = 8192;
constexpr float EPS = 1e-6f;
constexpr float NEGV = -1e30f;
constexpr float QSCALE = 0.125f;

constexpr long O_YP = 0;
constexpr long O_YS = 16777216;
constexpr long O_W0P = O_YS + 1048576;
constexpr long O_W1P = O_W0P + 65536;
constexpr long O_W2P = O_W1P + 262144;
constexpr long O_MKV = O_W2P + 1048576;
constexpr long O_W0S = O_MKV + 262144;
constexpr long O_W1S = O_W0S + 4194304;
constexpr long O_W2S = O_W1S + 16777216;
constexpr long O_GV = O_W2S + 67108864;

constexpr size_t A256(size_t x) { return (x + 255) & ~(size_t)255; }
constexpr size_t W_XB = 0;
constexpr size_t W_MEMB = A256(W_XB + (size_t)ROWS * 1024 * 2);
constexpr size_t W_RSTD = A256(W_MEMB + 512 * 1024 * 2);
constexpr size_t W_WINT = A256(W_RSTD + (ROWS + 512) * 4);
constexpr size_t W_WOUTT = A256(W_WINT + 3328 * 1024 * 2);
constexpr size_t W_WMEMT = A256(W_WOUTT + 1024 * 1024 * 2);
constexpr size_t W_WSB = A256(W_WMEMT + 512 * 1024 * 2);
constexpr size_t W_ROPE = A256(W_WSB + 6 * 128 * 128 * 2);
constexpr size_t W_U = A256(W_ROPE + 8200 * 8 * 8);
constexpr size_t W_GV = A256(W_U + (size_t)ROWS * 384 * 2);
constexpr size_t W_VSTAT = A256(W_GV + (size_t)ROWS * 384 * 2);
constexpr size_t W_SGA = A256(W_VSTAT + (size_t)ROWS * 12 * 4);
constexpr size_t W_QP = A256(W_SGA + (size_t)ROWS * 384 * 2);
constexpr size_t W_KP = A256(W_QP + 2 * 6 * 8192 * 64 * 2);
constexpr size_t W_VP = A256(W_KP + 2 * 6 * 8192 * 64 * 2);
constexpr size_t W_QS = A256(W_VP + 2 * 6 * 8192 * 64 * 2);
constexpr size_t W_SGB = A256(W_QS + 1024 * 384 * 4);
constexpr size_t W_QC = A256(W_SGB + (size_t)ROWS * 384 * 2);
constexpr size_t W_QCS = A256(W_QC + 16384 * 256 * 2);
constexpr size_t W_SGC = A256(W_QCS + 1024 * 256 * 4);
constexpr size_t W_MK = A256(W_SGC + (size_t)ROWS * 256 * 2);
constexpr size_t W_MV = A256(W_MK + 2 * 4 * 256 * 64 * 2);
constexpr size_t W_O = A256(W_MV + 2 * 4 * 256 * 64 * 2);
constexpr size_t W_LSE = A256(W_O + (size_t)ROWS * 384 * 2);
constexpr size_t W_MIX = A256(W_LSE + (size_t)ROWS * 6 * 4);
constexpr size_t W_CTL = A256(W_MIX + (size_t)ROWS * 1024 * 2);
constexpr size_t CTL_BYTES = 16384;
constexpr size_t W_END = A256(W_CTL + CTL_BYTES);

constexpr int LDS_BYTES = 131072;
constexpr int KSTR = 144, VSTR = 160;

struct Params {
  const float *x_prompt, *x_sample, *st0, *st1, *st2, *cache_mem, *mem_prompt, *norm_gain, *w_in, *ln_g, *ln_b,
      *w_s, *b_s, *q_norm, *k_norm, *mem_norm, *w_mem_kv, *mem_q_norm, *mem_k_norm, *w_out;
  float* out;
  char* ws;
  long phase_lo, phase_hi;
};

typedef __attribute__((ext_vector_type(2))) __bf16 bf16x2_t;
typedef __attribute__((ext_vector_type(2))) float f32x2_t;
DEVI unsigned pk2(float a, float b) {
  f32x2_t v = {a, b};
  return __builtin_bit_cast(unsigned, __builtin_convertvector(v, bf16x2_t));
}
DEVI u16 f2bf(float a) { return (u16)(pk2(a, 0.f) & 0xffffu); }
DEVI float bf2f(unsigned v) { return __uint_as_float(v << 16); }
DEVI float bflo(unsigned v) { return __uint_as_float(v << 16); }
DEVI float bfhi(unsigned v) { return __uint_as_float(v & 0xffff0000u); }
DEVI float gelu_f(float x) {
  const float z = fabsf(x) * 0.70710678118654752f;
  const float t = __builtin_amdgcn_rcpf(1.f + 0.3275911f * z);
  float poly = 1.061405429f;
  poly = poly * t - 1.453152027f;
  poly = poly * t + 1.421413741f;
  poly = poly * t - 0.284496736f;
  poly = poly * t + 0.254829592f;
  poly *= t;
  const float e = 1.f - poly * __expf(-z * z);
  const float erfv = x < 0.f ? -e : e;
  return 0.5f * x * (1.f + erfv);
}
DEVI float silu_f(float x) { return x * __builtin_amdgcn_rcpf(1.f + __expf(-x)); }
DEVI float red16(float x) {
  x += __builtin_bit_cast(float, __builtin_amdgcn_update_dpp(0, __builtin_bit_cast(int, x), 0xB1, 0xF, 0xF, true));
  x += __builtin_bit_cast(float, __builtin_amdgcn_update_dpp(0, __builtin_bit_cast(int, x), 0x4E, 0xF, 0xF, true));
  x += __builtin_bit_cast(float, __builtin_amdgcn_update_dpp(0, __builtin_bit_cast(int, x), 0x124, 0xF, 0xF, true));
  x += __builtin_bit_cast(float, __builtin_amdgcn_update_dpp(0, __builtin_bit_cast(int, x), 0x128, 0xF, 0xF, true));
  return x;
}
DEVI float max16(float x) {
  x = fmaxf(x, __builtin_bit_cast(float, __builtin_amdgcn_update_dpp(0, __builtin_bit_cast(int, x), 0xB1, 0xF, 0xF, true)));
  x = fmaxf(x, __builtin_bit_cast(float, __builtin_amdgcn_update_dpp(0, __builtin_bit_cast(int, x), 0x4E, 0xF, 0xF, true)));
  x = fmaxf(x, __builtin_bit_cast(float, __builtin_amdgcn_update_dpp(0, __builtin_bit_cast(int, x), 0x124, 0xF, 0xF, true)));
  x = fmaxf(x, __builtin_bit_cast(float, __builtin_amdgcn_update_dpp(0, __builtin_bit_cast(int, x), 0x128, 0xF, 0xF, true)));
  return x;
}
DEVI float wave_sum(float v) {
  v = red16(v);
  v += __shfl_xor(v, 16);
  v += __shfl_xor(v, 32);
  return v;
}
DEVI float wave_max(float v) {
  v = max16(v);
  v = fmaxf(v, __shfl_xor(v, 16));
  v = fmaxf(v, __shfl_xor(v, 32));
  return v;
}
DEVI f32x4 mfma16(bf16x8 a, bf16x8 b, f32x4 c) { return __builtin_amdgcn_mfma_f32_16x16x32_bf16(a, b, c, 0, 0, 0); }
DEVI s16x4 tr_read(const char* p) { return __builtin_amdgcn_ds_read_tr16_b64_v4i16((LAS s16x4*)p); }
DEVI bf16x8 cat8(s16x4 lo, s16x4 hi) { return (bf16x8){lo[0], lo[1], lo[2], lo[3], hi[0], hi[1], hi[2], hi[3]}; }


#define XB_TMO 128
#define XB_XCNT(j) (256 + 64 * (j))
#define XB_XSUB(j) (1280 + 64 * (j))
#define XB_XGEN(j) (2304 + 64 * (j))
#define XB_TOP 3328
#define XB_TOPGEN 3392
#define XCD_BAR_WORDS 3456
#define CTL_COPY_HEAD 3520
#define CTL_P1_DONE 3584
#define CTL_P4_DONE 3648
#define XB_SPIN_CAP (1u << 18)
DEVI unsigned xb_ld(unsigned* p) { return __hip_atomic_load(p, __ATOMIC_RELAXED, __HIP_MEMORY_SCOPE_AGENT); }
DEVI unsigned xb_add(unsigned* p, unsigned v) { return __hip_atomic_fetch_add(p, v, __ATOMIC_RELAXED, __HIP_MEMORY_SCOPE_AGENT); }
DEVI unsigned xb_xcc_id() { return (unsigned)__builtin_amdgcn_s_getreg((3 << 11) | 20) & 0xFu; }
#define XB_SPIN(cond, bar)                                                                    \
  do {                                                                                        \
    unsigned _sp = 0;                                                                         \
    while (cond) {                                                                            \
      __builtin_amdgcn_s_sleep(1);                                                            \
      if ((++_sp & 255u) == 0u) {                                                             \
        if (xb_ld(&(bar)[XB_TMO])) break;                                                     \
        if (_sp > XB_SPIN_CAP) { atomicAdd(&(bar)[XB_TMO], 1u); break; }                      \
      }                                                                                       \
    }                                                                                         \
  } while (0)
struct XcdBarrier { unsigned* bar; unsigned x; volatile LAS unsigned* st; };
DEVI XcdBarrier xcd_barrier_post(unsigned* bar, volatile LAS unsigned* st) {
  XcdBarrier b; b.bar = bar; b.x = xb_xcc_id(); b.st = st;
  if (threadIdx.x == 0) (void)xb_add(&bar[XB_XCNT(b.x)], 1u);
  return b;
}
DEVI void xcd_barrier_complete(unsigned* bar, unsigned x, unsigned& nloc, unsigned& nx) {
  const unsigned G = gridDim.x * gridDim.y * gridDim.z;
  unsigned sum, cnt, mine, sp = 0u;
  for (;;) {
    sum = 0u; cnt = 0u; mine = 0u;
#pragma unroll
    for (unsigned j = 0; j < 16; ++j) { const unsigned c = xb_ld(&bar[XB_XCNT(j)]); sum += c; cnt += (c > 0u) ? 1u : 0u; mine = (j == x) ? c : mine; }
    if (sum == G) break;
    __builtin_amdgcn_s_sleep(1);
    if ((++sp & 255u) == 0u) { if (xb_ld(&bar[XB_TMO])) break; if (sp > XB_SPIN_CAP) { atomicAdd(&bar[XB_TMO], 1u); break; } }
  }
  nloc = mine > 0u ? mine : 1u; nx = cnt > 0u ? cnt : 1u;
}
DEVI void xcd_barrier(const XcdBarrier& b) {
  asm volatile("s_waitcnt vmcnt(0)" ::: "memory");
  __syncthreads();
  if (threadIdx.x == 0) {
    unsigned* bar = b.bar;
    __builtin_amdgcn_s_waitcnt(0);
    unsigned nloc = b.st[0], nx = b.st[1];
    if (nloc == 0u) { xcd_barrier_complete(bar, b.x, nloc, nx); b.st[0] = nloc; b.st[1] = nx; }
    const unsigned old = xb_add(&bar[XB_XSUB(b.x)], 1u);
    const unsigned gen = old / nloc;
    if (old + 1u == (gen + 1u) * nloc) {
      __builtin_amdgcn_fence(__ATOMIC_RELEASE, "agent");
      asm volatile("s_waitcnt vmcnt(0)" ::: "memory");
      const unsigned og = xb_add(&bar[XB_TOP], 1u);
      const unsigned tg = og / nx;
      if (og + 1u == (tg + 1u) * nx) xb_add(&bar[XB_TOPGEN], 1u);
      else XB_SPIN(xb_ld(&bar[XB_TOPGEN]) == tg, bar);
      __builtin_amdgcn_fence(__ATOMIC_ACQUIRE, "agent");
      xb_add(&bar[XB_XGEN(b.x)], 1u);
      asm volatile("s_waitcnt vmcnt(0)" ::: "memory");
    } else {
      XB_SPIN(xb_ld(&bar[XB_XGEN(b.x)]) == gen, bar);
      __builtin_amdgcn_fence(__ATOMIC_ACQUIRE, "agent");
      asm volatile("s_waitcnt vmcnt(0)" ::: "memory");
    }
  }
  __syncthreads();
}

DEVI void gemm256(const u16* __restrict__ A, const u16* __restrict__ Bt, f32x4 (&acc)[2][2][4][2], char* shm, const int tid) {
  constexpr int K = 1024, BK = 64, HALF = 128;
  const int lane = tid & 63, wid = tid >> 6, wr = wid >> 2, wc = wid & 3, fr = lane & 15, fq = lane >> 4;
#define SA(b, h) (shm + ((b) * 2 + (h)) * 16384)
#define SB(b, h) (shm + (4 + (b) * 2 + (h)) * 16384)
  int sb_[2], go_[2];
#pragma unroll
  for (int i = 0; i < 2; ++i) {
    int b = tid * 16 + i * 8192;
    int st = b >> 10, sbb = b & 1023, swz = sbb ^ (((sbb >> 9) & 1) << 5);
    int R = (st >> 1) * 16 + (swz >> 6), C = (st & 1) * 32 + ((swz & 63) >> 1);
    sb_[i] = b; go_[i] = R * K + C;
  }
#define STAGE(P, BASE, br, kt)                                                                                          \
  do {                                                                                                                  \
    _Pragma("unroll") for (int _i = 0; _i < 2; ++_i) __builtin_amdgcn_global_load_lds(                                   \
        (const unsigned*)((BASE) + (long)(br) * K + (kt) * BK + go_[_i]), (LAS unsigned*)((P) + sb_[_i]), 16, 0, 0);     \
  } while (0)
  const int obs = (fr * 64 + fq * 16) ^ (((fr >> 3) & 1) << 5);
  const int aoff = wr * 8192 + obs, boff = wc * 4096 + obs;
#define LDA(dst, b, h)                                                                                  \
  _Pragma("unroll") for (int m = 0; m < 4; ++m) _Pragma("unroll") for (int k = 0; k < 2; ++k) dst[m][k] = \
      *(const bf16x8*)(SA(b, h) + aoff + (m * 2 + k) * 1024)
#define LDB(dst, b, h)                                                                                  \
  _Pragma("unroll") for (int n = 0; n < 2; ++n) _Pragma("unroll") for (int k = 0; k < 2; ++k) dst[n][k] = \
      *(const bf16x8*)(SB(b, h) + boff + (n * 2 + k) * 1024)
#define MMA(ai, bj, At, Bx)                                                                                             \
  do {                                                                                                                  \
    __builtin_amdgcn_s_setprio(1);                                                                                      \
    _Pragma("unroll") for (int m = 0; m < 4; ++m) _Pragma("unroll") for (int n = 0; n < 2; ++n) _Pragma("unroll") for ( \
        int k = 0; k < 2; ++k) acc[ai][bj][m][n] = mfma16(At[m][k], Bx[n][k], acc[ai][bj][m][n]);                        \
    __builtin_amdgcn_s_setprio(0);                                                                                      \
  } while (0)
#define WAIT_V(n) asm volatile("s_waitcnt vmcnt(" #n ")" ::: "memory")
#define WAIT_L(n) asm volatile("s_waitcnt lgkmcnt(" #n ")" ::: "memory")
#define BAR __builtin_amdgcn_s_barrier()
#define SCHED __builtin_amdgcn_sched_barrier(0)
#pragma unroll
  for (int a = 0; a < 2; ++a)
#pragma unroll
    for (int b = 0; b < 2; ++b)
#pragma unroll
      for (int m = 0; m < 4; ++m)
#pragma unroll
        for (int n = 0; n < 2; ++n) acc[a][b][m][n] = (f32x4){0.f, 0.f, 0.f, 0.f};
  bf16x8 At[4][2], B0[2][2], B1[2][2];
  constexpr int nt = K / BK;
  WAIT_V(0);
  STAGE(SB(0, 0), Bt, 0, 0); STAGE(SA(0, 0), A, 0, 0);
  STAGE(SB(0, 1), Bt, HALF, 0); STAGE(SA(0, 1), A, HALF, 0);
  if (wr == 1) BAR;
  WAIT_V(4); BAR;
  STAGE(SB(1, 0), Bt, 0, 1); STAGE(SA(1, 0), A, 0, 1); STAGE(SB(1, 1), Bt, HALF, 1);
  WAIT_V(6); BAR;
#pragma unroll 1
  for (int t = 0; t < nt - 2; t += 2) {
    LDB(B0, 0, 0); SCHED; LDA(At, 0, 0); STAGE(SA(1, 1), A, HALF, t + 1);
    WAIT_L(8); BAR; WAIT_L(0); MMA(0, 0, At, B0); BAR; SCHED;
    LDB(B1, 0, 1); STAGE(SB(0, 0), Bt, 0, t + 2);
    BAR; WAIT_L(0); MMA(0, 1, At, B1); BAR;
    LDA(At, 0, 1); STAGE(SA(0, 0), A, 0, t + 2);
    BAR; WAIT_L(0); MMA(1, 0, At, B0); BAR; SCHED;
    STAGE(SB(0, 1), Bt, HALF, t + 2);
    WAIT_V(6); BAR; MMA(1, 1, At, B1); BAR;
    LDB(B0, 1, 0); SCHED; LDA(At, 1, 0); STAGE(SA(0, 1), A, HALF, t + 2);
    WAIT_L(8); BAR; WAIT_L(0); MMA(0, 0, At, B0); BAR; SCHED;
    LDB(B1, 1, 1); STAGE(SB(1, 0), Bt, 0, t + 3);
    BAR; WAIT_L(0); MMA(0, 1, At, B1); BAR;
    LDA(At, 1, 1); STAGE(SA(1, 0), A, 0, t + 3);
    BAR; WAIT_L(0); MMA(1, 0, At, B0); BAR; SCHED;
    STAGE(SB(1, 1), Bt, HALF, t + 3);
    WAIT_V(6); BAR; MMA(1, 1, At, B1); BAR;
  }
  {
    LDB(B0, 0, 0); LDA(At, 0, 0); STAGE(SA(1, 1), A, HALF, nt - 1);
    BAR; WAIT_L(0); MMA(0, 0, At, B0); BAR;
    LDB(B1, 0, 1); BAR; WAIT_L(0); MMA(0, 1, At, B1); BAR;
    LDA(At, 0, 1); WAIT_V(4); BAR; WAIT_L(0); MMA(1, 0, At, B0); MMA(1, 1, At, B1); BAR;
  }
  {
    LDB(B0, 1, 0); LDA(At, 1, 0); WAIT_V(2); BAR; WAIT_L(0); MMA(0, 0, At, B0); BAR;
    LDB(B1, 1, 1); WAIT_V(0); BAR; WAIT_L(0); MMA(0, 1, At, B1); BAR;
    LDA(At, 1, 1); BAR; WAIT_L(0); MMA(1, 0, At, B0); MMA(1, 1, At, B1); BAR;
  }
  if (wr == 0) BAR;
#undef SA
#undef SB
#undef STAGE
#undef LDA
#undef LDB
#undef MMA
}

DEVI void transpose_w(const float* __restrict__ w, const float* __restrict__ gain, u16* __restrict__ wt, int N, int gtid, int gsz) {
  const int items = N * 128;
  for (int idx = gtid; idx < items; idx += gsz) {
    int n = idx % N, kc = idx / N;
    float v[8];
#pragma unroll
    for (int e = 0; e < 8; ++e) {
      int k = kc * 8 + e;
      float x = w[(long)k * N + n];
      if (gain) x *= gain[k];
      v[e] = x;
    }
    uint4 o = {pk2(v[0], v[1]), pk2(v[2], v[3]), pk2(v[4], v[5]), pk2(v[6], v[7])};
    *(uint4*)(wt + (long)n * 1024 + kc * 8) = o;
  }
}

DEVI void phase0(const Params& p) {
  const int gtid = blockIdx.x * NT + threadIdx.x, gsz = gridDim.x * NT;
  const int gw = gtid >> 6, nw = gsz >> 6, lane = threadIdx.x & 63;
  u16* XB = (u16*)(p.ws + W_XB);
  u16* MEMB = (u16*)(p.ws + W_MEMB);
  float* RSTD = (float*)(p.ws + W_RSTD);
  const float* const xp_ = p.x_prompt; const float* const xs_ = p.x_sample; const float* const mp_ = p.mem_prompt;
  for (int r0 = gw; r0 < ROWS + 512; r0 += 3 * nw) {
    float4 v[3][4];
#pragma unroll
    for (int q = 0; q < 3; ++q) {
      const int r = min(r0 + q * nw, ROWS + 511);
      const float* src = r < PROWS ? xp_ + (long)r * 1024 : (r < ROWS ? xs_ + (long)(r - PROWS) * 1024 : mp_ + (long)(r - ROWS) * 1024);
#pragma unroll
      for (int i = 0; i < 4; ++i) v[q][i] = ((const float4*)src)[i * 64 + lane];
    }
#pragma unroll
    for (int q = 0; q < 3; ++q) {
      const int r = r0 + q * nw;
      if (r < ROWS + 512) {
        u16* dst = r < ROWS ? XB + (long)r * 1024 : MEMB + (long)(r - ROWS) * 1024;
        float ss = 0.f;
#pragma unroll
        for (int i = 0; i < 4; ++i) {
          ss += v[q][i].x * v[q][i].x + v[q][i].y * v[q][i].y + v[q][i].z * v[q][i].z + v[q][i].w * v[q][i].w;
          uint2 o = {pk2(v[q][i].x, v[q][i].y), pk2(v[q][i].z, v[q][i].w)};
          ((uint2*)dst)[i * 64 + lane] = o;
        }
        ss = wave_sum(ss);
        if (lane == 0) RSTD[r] = rsqrtf(ss * (1.f / 1024.f) + EPS);
      }
    }
  }
  transpose_w(p.w_in, p.norm_gain, (u16*)(p.ws + W_WINT), 3200, gtid, gsz);
  {
    uint4* z = (uint4*)(p.ws + W_WINT + (size_t)3200 * 1024 * 2);
    for (int idx = gtid; idx < 128 * 1024 * 2 / 16; idx += gsz) z[idx] = make_uint4(0, 0, 0, 0);
  }
  transpose_w(p.w_out, nullptr, (u16*)(p.ws + W_WOUTT), 1024, gtid, gsz);
  transpose_w(p.w_mem_kv, p.mem_norm, (u16*)(p.ws + W_WMEMT), 512, gtid, gsz);
  u16* WSB = (u16*)(p.ws + W_WSB);
  for (int idx = gtid; idx < 6 * 128 * 128; idx += gsz) {
    int t = (idx >> 7) & 127, s = idx & 127;
    WSB[idx] = (s <= t) ? f2bf(p.w_s[idx]) : (u16)0;
  }
  float2* ROPE = (float2*)(p.ws + W_ROPE);
  for (int idx = gtid; idx < 8200 * 8; idx += gsz) {
    int pos = idx >> 3, i = idx & 7;
    float inv = i == 0 ? 1.0f : i == 1 ? 0.19392274f : i == 2 ? 0.03760603f : i == 3 ? 0.0072926646f : i == 4 ? 0.0014142136f
              : i == 5 ? 0.00027424818f : i == 6 ? 5.3182957e-05f : 1.0313385e-05f;
    float ang = (float)pos * inv;
    float sn, cs;
    sincosf(ang, &sn, &cs);
    ROPE[idx] = make_float2(cs, sn);
  }
}

#define QV(m, np) q[(np) >> 1][m][(np) & 1]
DEVI void epi_act(f32x4 (&q)[2][4][2], const float* rs, u16* dst, int dstride, int col0, int tokb, bool use_gelu, const int lane) {
  const int fq = lane >> 4;
#pragma unroll
  for (int np = 0; np < 4; ++np) {
    long tok = tokb + (np >> 1) * 128 + (np & 1) * 16;
#pragma unroll
    for (int m = 0; m < 4; ++m) {
      float v[4];
#pragma unroll
      for (int j = 0; j < 4; ++j) {
        float x = QV(m, np)[j] * rs[np];
        v[j] = use_gelu ? gelu_f(x) : silu_f(x);
      }
      uint2 o = {pk2(v[0], v[1]), pk2(v[2], v[3])};
      *(uint2*)(dst + tok * dstride + col0 + m * 16 + fq * 4) = o;
    }
  }
}

DEVI void head_norm(f32x4 (&q)[2][4][2], const float* rs, const float* __restrict__ gain, float scale, bool rot, const int* pos,
                    const float2* __restrict__ ROPE, const int lane) {
  const int fq = lane >> 4;
  float g[4][4];
#pragma unroll
  for (int m = 0; m < 4; ++m) {
    float4 gv = *(const float4*)(gain + m * 16 + fq * 4);
    g[m][0] = gv.x * scale; g[m][1] = gv.y * scale; g[m][2] = gv.z * scale; g[m][3] = gv.w * scale;
  }
#pragma unroll
  for (int np = 0; np < 4; ++np) {
    float ss = 0.f;
#pragma unroll
    for (int m = 0; m < 4; ++m)
#pragma unroll
      for (int j = 0; j < 4; ++j) {
        float x = QV(m, np)[j] * rs[np];
        QV(m, np)[j] = x;
        ss += x * x;
      }
    ss += __shfl_xor(ss, 16);
    ss += __shfl_xor(ss, 32);
    float r = rsqrtf(ss * (1.f / 64.f) + EPS);
#pragma unroll
    for (int m = 0; m < 4; ++m)
#pragma unroll
      for (int j = 0; j < 4; ++j) QV(m, np)[j] *= r * g[m][j];
    if (rot) {
#pragma unroll
      for (int j = 0; j < 4; ++j) {
        float x = QV(0, np)[j];
        float y = __shfl_xor(x, 32);
        float2 cs = ROPE[pos[np] * 8 + (fq & 1) * 4 + j];
        QV(0, np)[j] = (fq < 2) ? (x * cs.x - y * cs.y) : (x * cs.x + y * cs.y);
      }
    }
  }
}

DEVI int perm_pos(int t, int sh) { return ((t & ((1 << sh) - 1)) << (13 - sh)) + (t >> sh); }

DEVI void phase1_group(char* ws_, float* out_, const Params& p, f32x4 (&q)[2][4][2], int cg, int tokb, bool sample, const int lane) {
  const int fq = lane >> 4;
  const float* RSTD = (const float*)(ws_ + W_RSTD);
  const float2* ROPE = (const float2*)(ws_ + W_ROPE);
  float rs[4];
  int pos[4];
#pragma unroll
  for (int np = 0; np < 4; ++np) {
    int tok = tokb + (np >> 1) * 128 + (np & 1) * 16;
    rs[np] = RSTD[tok];
    pos[np] = sample ? (SEQ + ((tok - PROWS) & 7)) : (tok & (SEQ - 1));
  }
  if (cg < 6) {
    epi_act(q, rs, (u16*)(ws_ + W_U), 384, cg * 64, tokb, true, lane);
  } else if (cg < 12) {
    u16* GV = (u16*)(ws_ + W_GV);
    float* VSTAT = (float*)(ws_ + W_VSTAT);
#pragma unroll
    for (int np = 0; np < 4; ++np) {
      long tok = tokb + (np >> 1) * 128 + (np & 1) * 16;
      float s1 = 0.f, s2 = 0.f;
#pragma unroll
      for (int m = 0; m < 4; ++m) {
        float v[4];
#pragma unroll
        for (int j = 0; j < 4; ++j) {
          float x = bf2f(f2bf(gelu_f(QV(m, np)[j] * rs[np])));
          v[j] = x; s1 += x; s2 += x * x;
        }
        uint2 o = {pk2(v[0], v[1]), pk2(v[2], v[3])};
        *(uint2*)(GV + tok * 384 + (cg - 6) * 64 + m * 16 + fq * 4) = o;
      }
      s1 += __shfl_xor(s1, 16); s2 += __shfl_xor(s2, 16);
      s1 += __shfl_xor(s1, 32); s2 += __shfl_xor(s2, 32);
      if (fq == 0) *(float2*)(VSTAT + (tok * 6 + (cg - 6)) * 2) = make_float2(s1, s2);
    }
  } else if (cg < 18) {
    epi_act(q, rs, (u16*)(ws_ + W_SGA), 384, (cg - 12) * 64, tokb, false, lane);
  } else if (cg < 24) {
    const int h = cg - 18, sh = (h >> 1) * 2;
    head_norm(q, rs, p.q_norm, QSCALE, true, pos, ROPE, lane);
    if (!sample) {
      u16* QP = (u16*)(ws_ + W_QP);
#pragma unroll
      for (int np = 0; np < 4; ++np) {
        int tok = tokb + (np >> 1) * 128 + (np & 1) * 16, b = tok >> 13, t = tok & (SEQ - 1);
        long base = ((long)(b * 6 + h) * SEQ + perm_pos(t, sh)) * 64;
#pragma unroll
        for (int m = 0; m < 4; ++m) {
          uint2 o = {pk2(QV(m, np)[0], QV(m, np)[1]), pk2(QV(m, np)[2], QV(m, np)[3])};
          *(uint2*)(QP + base + m * 16 + fq * 4) = o;
        }
      }
    } else {
      float* QS = (float*)(ws_ + W_QS);
#pragma unroll
      for (int np = 0; np < 4; ++np) {
        int srow = tokb + (np >> 1) * 128 + (np & 1) * 16 - PROWS;
#pragma unroll
        for (int m = 0; m < 4; ++m)
          *(float4*)(QS + (long)srow * 384 + h * 64 + m * 16 + fq * 4) = make_float4(QV(m, np)[0], QV(m, np)[1], QV(m, np)[2], QV(m, np)[3]);
      }
    }
  } else if (cg < 36) {
    const bool isk = cg < 30;
    const int h = isk ? cg - 24 : cg - 30, g = h >> 1, jh = h & 1, sh = g * 2, kv = isk ? 0 : 1;
    const int W = 128 << sh;
    if (isk) {
      head_norm(q, rs, p.k_norm, 1.f, true, pos, ROPE, lane);
    } else {
#pragma unroll
      for (int np = 0; np < 4; ++np)
#pragma unroll
        for (int m = 0; m < 4; ++m)
#pragma unroll
          for (int j = 0; j < 4; ++j) QV(m, np)[j] *= rs[np];
    }
    if (!sample) {
      u16* KP = (u16*)(ws_ + (isk ? W_KP : W_VP));
      float* wout = out_ + (g == 0 ? O_W0P : (g == 1 ? O_W1P : O_W2P));
#pragma unroll
      for (int np = 0; np < 4; ++np) {
        int tok = tokb + (np >> 1) * 128 + (np & 1) * 16, b = tok >> 13, t = tok & (SEQ - 1);
        long base = ((long)(b * 6 + h) * SEQ + perm_pos(t, sh)) * 64;
#pragma unroll
        for (int m = 0; m < 4; ++m) {
          uint2 o = {pk2(QV(m, np)[0], QV(m, np)[1]), pk2(QV(m, np)[2], QV(m, np)[3])};
          *(uint2*)(KP + base + m * 16 + fq * 4) = o;
        }
        if (t >= SEQ - W) {
          long ob = ((((long)b * W + (t - (SEQ - W))) * 2 + kv) * 2 + jh) * 64;
#pragma unroll
          for (int m = 0; m < 4; ++m)
            *(float4*)(wout + ob + m * 16 + fq * 4) = make_float4(QV(m, np)[0], QV(m, np)[1], QV(m, np)[2], QV(m, np)[3]);
        }
      }
    } else {
      float* wout = out_ + (g == 0 ? O_W0S : (g == 1 ? O_W1S : O_W2S));
#pragma unroll
      for (int np = 0; np < 4; ++np) {
        int srow = tokb + (np >> 1) * 128 + (np & 1) * 16 - PROWS, b = srow >> 3, t = srow & 7;
        long ob = ((((long)b * W + (W - 8 + t)) * 2 + kv) * 2 + jh) * 64;
#pragma unroll
        for (int m = 0; m < 4; ++m)
          *(float4*)(wout + ob + m * 16 + fq * 4) = make_float4(QV(m, np)[0], QV(m, np)[1], QV(m, np)[2], QV(m, np)[3]);
      }
    }
  } else if (cg < 42) {
    epi_act(q, rs, (u16*)(ws_ + W_SGB), 384, (cg - 36) * 64, tokb, false, lane);
  } else if (cg < 46) {
    const int mh = cg - 42;
    head_norm(q, rs, p.mem_q_norm, QSCALE, false, pos, ROPE, lane);
    if (!sample) {
      u16* QC = (u16*)(ws_ + W_QC);
#pragma unroll
      for (int np = 0; np < 4; ++np) {
        long tok = tokb + (np >> 1) * 128 + (np & 1) * 16;
#pragma unroll
        for (int m = 0; m < 4; ++m) {
          uint2 o = {pk2(QV(m, np)[0], QV(m, np)[1]), pk2(QV(m, np)[2], QV(m, np)[3])};
          *(uint2*)(QC + tok * 256 + mh * 64 + m * 16 + fq * 4) = o;
        }
      }
    } else {
      float* QCS = (float*)(ws_ + W_QCS);
#pragma unroll
      for (int np = 0; np < 4; ++np) {
        int srow = tokb + (np >> 1) * 128 + (np & 1) * 16 - PROWS;
#pragma unroll
        for (int m = 0; m < 4; ++m)
          *(float4*)(QCS + (long)srow * 256 + mh * 64 + m * 16 + fq * 4) = make_float4(QV(m, np)[0], QV(m, np)[1], QV(m, np)[2], QV(m, np)[3]);
      }
    }
  } else if (cg < 50) {
    epi_act(q, rs, (u16*)(ws_ + W_SGC), 256, (cg - 46) * 64, tokb, false, lane);
  }
}

DEVI void memkv_group(char* ws_, float* out_, const Params& p, f32x4 (&q)[2][4][2], int cgm, int rowb, const int lane) {
  const int fq = lane >> 4;
  const float* MR = (const float*)(ws_ + W_RSTD) + ROWS;
  const float2* ROPE = (const float2*)(ws_ + W_ROPE);
  float* mout = out_ + O_MKV;
  float rs[4];
  int pos[4] = {0, 0, 0, 0};
#pragma unroll
  for (int np = 0; np < 4; ++np) rs[np] = MR[rowb + (np >> 1) * 128 + (np & 1) * 16];
  const bool isk = cgm < 4;
  const int mh = cgm & 3;
  if (isk) {
    head_norm(q, rs, p.mem_k_norm, 1.f, false, pos, ROPE, lane);
  } else {
#pragma unroll
    for (int np = 0; np < 4; ++np)
#pragma unroll
      for (int m = 0; m < 4; ++m)
#pragma unroll
        for (int j = 0; j < 4; ++j) QV(m, np)[j] *= rs[np];
  }
  u16* MKV = (u16*)(ws_ + (isk ? W_MK : W_MV));
#pragma unroll
  for (int np = 0; np < 4; ++np) {
    int row = rowb + (np >> 1) * 128 + (np & 1) * 16, b = row >> 8, mm = row & 255;
#pragma unroll
    for (int m = 0; m < 4; ++m) {
      uint2 o = {pk2(QV(m, np)[0], QV(m, np)[1]), pk2(QV(m, np)[2], QV(m, np)[3])};
      *(uint2*)(MKV + ((long)(b * 4 + mh) * 256 + mm) * 64 + m * 16 + fq * 4) = o;
      *(float4*)(mout + (((long)row * 2 + (isk ? 0 : 1)) * 4 + mh) * 64 + m * 16 + fq * 4) =
          make_float4(QV(m, np)[0], QV(m, np)[1], QV(m, np)[2], QV(m, np)[3]);
    }
  }
}

constexpr int P1_TILES = 68 * 13, P1_ALL = P1_TILES + 4;
DEVI void phase1_tile(const Params& p, char* lds, int tile) {
  unsigned long wsi_ = (unsigned long)p.ws; asm volatile("" : "+s"(wsi_)); char* ws_ = (char*)(GAS char*)wsi_;
  unsigned long outi_ = (unsigned long)p.out; asm volatile("" : "+s"(outi_)); float* out_ = (float*)(GAS float*)outi_;
  int tid_ = threadIdx.x; asm volatile("" : "+v"(tid_));
  const int tid = tid_, lane = tid & 63, wid = tid >> 6, wr = wid >> 2, wc = wid & 3, fr = lane & 15;
  f32x4 acc[2][2][4][2];
  if (tile < P1_TILES) {
    const int mt = tile / 13, nt = tile % 13;
    gemm256((const u16*)(ws_ + W_WINT) + (long)nt * 256 * 1024, (const u16*)(ws_ + W_XB) + (long)mt * 256 * 1024, acc, lds, tid);
    const int tokb = mt * 256 + wc * 32 + fr;
    __builtin_amdgcn_sched_barrier(0);
    phase1_group(ws_, out_, p, acc[0], nt * 4 + wr, tokb, mt >= 64, lane);
    __builtin_amdgcn_sched_barrier(0);
    phase1_group(ws_, out_, p, acc[1], nt * 4 + 2 + wr, tokb, mt >= 64, lane);
  } else {
    const int t2 = tile - P1_TILES, mt = t2 >> 1, nt = t2 & 1;
    gemm256((const u16*)(ws_ + W_WMEMT) + (long)nt * 256 * 1024, (const u16*)(ws_ + W_MEMB) + (long)mt * 256 * 1024, acc, lds, tid);
    const int rowb = mt * 256 + wc * 32 + fr;
    __builtin_amdgcn_sched_barrier(0);
    memkv_group(ws_, out_, p, acc[0], nt * 4 + wr, rowb, lane);
    __builtin_amdgcn_sched_barrier(0);
    memkv_group(ws_, out_, p, acc[1], nt * 4 + 2 + wr, rowb, lane);
  }
}

template <bool DIL>
DEVI void attn_task(const Params& p, char* lds, int task) {
  unsigned long wsi_ = (unsigned long)p.ws; asm volatile("" : "+s"(wsi_)); char* ws_ = (char*)(GAS char*)wsi_;
  int tid_ = threadIdx.x; asm volatile("" : "+v"(tid_));
  const int tid = tid_, lane = tid & 63, w = tid >> 6, fr = lane & 15, fq = lane >> 4;
  char* Kl = lds;
  char* Vl = lds + 256 * KSTR;
  int b, h, j, sh = 0;
  bool hasprev = true;
  const u16 *Kg, *Vg, *Qg;
  long qstride;
  int kprev0, kown0;
  if (DIL) {
    b = task / 384; h = (task >> 6) % 6; j = task & 63;
    sh = (h >> 1) * 2;
    hasprev = (j & ((64 >> sh) - 1)) != 0;
    Kg = (const u16*)(ws_ + W_KP) + (long)(b * 6 + h) * SEQ * 64;
    Vg = (const u16*)(ws_ + W_VP) + (long)(b * 6 + h) * SEQ * 64;
    Qg = (const u16*)(ws_ + W_QP) + ((long)(b * 6 + h) * SEQ + j * 128) * 64;
    qstride = 64;
    kown0 = j * 128 - 128;
    kprev0 = hasprev ? (j - 1) * 128 : j * 128;
  } else {
    b = task >> 8; h = (task >> 6) & 3; j = task & 63;
    Kg = (const u16*)(ws_ + W_MK) + (long)(b * 4 + h) * 256 * 64;
    Vg = (const u16*)(ws_ + W_MV) + (long)(b * 4 + h) * 256 * 64;
    Qg = (const u16*)(ws_ + W_QC) + ((long)b * SEQ + j * 128) * 256 + h * 64;
    qstride = 256;
    kown0 = 0; kprev0 = 0;
  }
  const int sb = w;
  bf16x8 qf[2];
  uint2 gcv[4];
  {
    const u16* qrow = Qg + (long)(sb * 16 + fr) * qstride;
    qf[0] = *(const bf16x8*)(qrow + fq * 8);
    qf[1] = *(const bf16x8*)(qrow + 32 + fq * 8);
    if (!DIL) {
      const long row = (long)b * SEQ + j * 128 + sb * 16 + fr;
      const u16* SGC = (const u16*)(ws_ + W_SGC);
#pragma unroll
      for (int dt = 0; dt < 4; ++dt) gcv[dt] = *(const uint2*)(SGC + row * 256 + h * 64 + dt * 16 + fq * 4);
    }
  }
  __syncthreads();
#pragma unroll
  for (int i = 0; i < 4; ++i) {
    int c = tid + i * NT;
    int key = c >> 3, part = c & 7;
    int src = (key < 128 ? kprev0 : kown0) + key;
    uint4 kvv = *(const uint4*)(Kg + (long)src * 64 + part * 8);
    uint4 vvv = *(const uint4*)(Vg + (long)src * 64 + part * 8);
    *(uint4*)(Kl + key * KSTR + part * 16) = kvv;
    *(uint4*)(Vl + key * VSTR + part * 16) = vvv;
  }
  __syncthreads();
  {
    f32x4 s[16];
#pragma unroll
    for (int kt = 0; kt < 16; ++kt) {
      s[kt] = (f32x4){0.f, 0.f, 0.f, 0.f};
#pragma unroll
      for (int ks = 0; ks < 2; ++ks) {
        bf16x8 a = *(const bf16x8*)(Kl + (kt * 16 + fr) * KSTR + ks * 64 + fq * 16);
        s[kt] = mfma16(a, qf[ks], s[kt]);
      }
      if ((kt & 3) == 3) __builtin_amdgcn_sched_barrier(0);
    }
    const int qo = sb * 16 + fr;
    float mx = -3.0e38f;
#pragma unroll
    for (int kt = 0; kt < 16; ++kt)
#pragma unroll
      for (int jj = 0; jj < 4; ++jj) {
        if (DIL) {
          int ko = kt * 16 + fq * 4 + jj;
          bool valid = (ko < 128) ? (hasprev && ko >= qo) : (ko - 128 <= qo);
          if (!valid) s[kt][jj] = NEGV;
        }
        mx = fmaxf(mx, s[kt][jj]);
      }
    mx = fmaxf(mx, __shfl_xor(mx, 16));
    mx = fmaxf(mx, __shfl_xor(mx, 32));
    float l = 0.f;
#pragma unroll
    for (int kt = 0; kt < 16; ++kt)
#pragma unroll
      for (int jj = 0; jj < 4; ++jj) {
        float e = __expf(s[kt][jj] - mx);
        s[kt][jj] = e;
        l += e;
      }
    l += __shfl_xor(l, 16);
    l += __shfl_xor(l, 32);
    const float il = __builtin_amdgcn_rcpf(l);
    f32x4 o[4];
#pragma unroll
    for (int dt = 0; dt < 4; ++dt) o[dt] = (f32x4){0.f, 0.f, 0.f, 0.f};
    const char* vbase = Vl + (fq * 4 + (fr >> 2)) * VSTR + (fr & 3) * 8;
#pragma unroll
    for (int kk = 0; kk < 8; ++kk) {
      union { bf16x8 v; unsigned u[4]; } pf;
      pf.u[0] = pk2(s[2 * kk][0] * il, s[2 * kk][1] * il);
      pf.u[1] = pk2(s[2 * kk][2] * il, s[2 * kk][3] * il);
      pf.u[2] = pk2(s[2 * kk + 1][0] * il, s[2 * kk + 1][1] * il);
      pf.u[3] = pk2(s[2 * kk + 1][2] * il, s[2 * kk + 1][3] * il);
#pragma unroll
      for (int dt = 0; dt < 4; ++dt) {
        s16x4 lo = tr_read(vbase + (kk * 32) * VSTR + dt * 32);
        s16x4 hi = tr_read(vbase + (kk * 32 + 16) * VSTR + dt * 32);
        o[dt] = mfma16(cat8(lo, hi), pf.v, o[dt]);
      }
      __builtin_amdgcn_sched_barrier(0);
    }
    if (DIL) {
      int pp = j * 128 + qo;
      int t = ((pp & ((SEQ >> sh) - 1)) << sh) + (pp >> (13 - sh));
      long row = (long)b * SEQ + t;
      u16* O = (u16*)(ws_ + W_O);
#pragma unroll
      for (int dt = 0; dt < 4; ++dt) {
        uint2 ov = {pk2(o[dt][0], o[dt][1]), pk2(o[dt][2], o[dt][3])};
        *(uint2*)(O + row * 384 + h * 64 + dt * 16 + fq * 4) = ov;
      }
      if (fq == 0) ((float*)(ws_ + W_LSE))[row * 6 + h] = mx + __logf(l);
    } else {
      long row = (long)b * SEQ + j * 128 + qo;
      u16* MIX = (u16*)(ws_ + W_MIX);
#pragma unroll
      for (int dt = 0; dt < 4; ++dt) {
        uint2 ov = {pk2(o[dt][0] * bflo(gcv[dt].x), o[dt][1] * bfhi(gcv[dt].x)), pk2(o[dt][2] * bflo(gcv[dt].y), o[dt][3] * bfhi(gcv[dt].y))};
        *(uint2*)(MIX + row * 1024 + 768 + h * 64 + dt * 16 + fq * 4) = ov;
      }
    }
  }
}

DEVI void gmlp_task(const Params& p, char* lds, int task) {
  unsigned long wsi_ = (unsigned long)p.ws; asm volatile("" : "+s"(wsi_)); char* ws_ = (char*)(GAS char*)wsi_;
  int tid_ = threadIdx.x; asm volatile("" : "+v"(tid_));
  const int tid = tid_, lane = tid & 63, w = tid >> 6, fr = lane & 15, fq = lane >> 4;
  const int chunk = task / 6, g = task % 6;
  float* mu = (float*)lds;
  float* rstd = mu + 128;
  char* Vl = lds + 1024;
  const float* VSTAT = (const float*)(ws_ + W_VSTAT);
  const u16* GV = (const u16*)(ws_ + W_GV);
  const u16* WSB = (const u16*)(ws_ + W_WSB) + (long)g * 128 * 128;
  const int t = w * 16 + fr;
  uint2 wf[4][2], uvp[4], gvp[4];
#pragma unroll
  for (int ks = 0; ks < 4; ++ks) {
    wf[ks][0] = *(const uint2*)(WSB + (long)t * 128 + ks * 32 + fq * 4);
    wf[ks][1] = *(const uint2*)(WSB + (long)t * 128 + ks * 32 + 16 + fq * 4);
  }
  {
    const long row = (long)chunk * 128 + t;
#pragma unroll
    for (int m = 0; m < 4; ++m) {
      uvp[m] = *(const uint2*)((const u16*)(ws_ + W_U) + row * 384 + g * 64 + m * 16 + fq * 4);
      gvp[m] = *(const uint2*)((const u16*)(ws_ + W_SGA) + row * 384 + g * 64 + m * 16 + fq * 4);
    }
  }
  const float bs = p.b_s[g * 128 + t];
  __syncthreads();
  if (tid < 128) {
    long row = (long)chunk * 128 + tid;
    float s1 = 0.f, s2 = 0.f;
#pragma unroll
    for (int i = 0; i < 6; ++i) { float2 v = *(const float2*)(VSTAT + (row * 6 + i) * 2); s1 += v.x; s2 += v.y; }
    float m = s1 * (1.f / 384.f);
    float var = fmaxf(s2 * (1.f / 384.f) - m * m, 0.f);
    mu[tid] = m;
    rstd[tid] = rsqrtf(var + EPS);
  }
  __syncthreads();
#pragma unroll
  for (int i = 0; i < 2; ++i) {
    int c = tid + i * NT;
    int s = c >> 3, part = c & 7;
    int col = g * 64 + part * 8;
    uint4 v = *(const uint4*)(GV + ((long)chunk * 128 + s) * 384 + col);
    float4 g0 = *(const float4*)(p.ln_g + col), g1 = *(const float4*)(p.ln_g + col + 4);
    float4 b0 = *(const float4*)(p.ln_b + col), b1 = *(const float4*)(p.ln_b + col + 4);
    float m = mu[s], r = rstd[s];
    unsigned o0 = pk2((bflo(v.x) - m) * r * g0.x + b0.x, (bfhi(v.x) - m) * r * g0.y + b0.y);
    unsigned o1 = pk2((bflo(v.y) - m) * r * g0.z + b0.z, (bfhi(v.y) - m) * r * g0.w + b0.w);
    unsigned o2 = pk2((bflo(v.z) - m) * r * g1.x + b1.x, (bfhi(v.z) - m) * r * g1.y + b1.y);
    unsigned o3 = pk2((bflo(v.w) - m) * r * g1.z + b1.z, (bfhi(v.w) - m) * r * g1.w + b1.w);
    *(uint4*)(Vl + s * VSTR + part * 16) = make_uint4(o0, o1, o2, o3);
  }
  __syncthreads();
  f32x4 acc[4];
#pragma unroll
  for (int m = 0; m < 4; ++m) acc[m] = (f32x4){0.f, 0.f, 0.f, 0.f};
  const char* vbase = Vl + (fq * 4 + (fr >> 2)) * VSTR + (fr & 3) * 8;
#pragma unroll
  for (int ks = 0; ks < 4; ++ks) {
    if (ks * 32 <= w * 16 + 15) {
      union { bf16x8 v; uint2 u[2]; } bw;
      bw.u[0] = wf[ks][0];
      bw.u[1] = wf[ks][1];
#pragma unroll
      for (int m = 0; m < 4; ++m) {
        s16x4 lo = tr_read(vbase + (ks * 32) * VSTR + m * 32);
        s16x4 hi = tr_read(vbase + (ks * 32 + 16) * VSTR + m * 32);
        acc[m] = mfma16(cat8(lo, hi), bw.v, acc[m]);
      }
    }
  }
  u16* MIX = (u16*)(ws_ + W_MIX);
  {
    long row = (long)chunk * 128 + t;
#pragma unroll
    for (int m = 0; m < 4; ++m) {
      int c = g * 64 + m * 16 + fq * 4;
      uint2 uv = uvp[m];
      uint2 gv = gvp[m];
      float r0 = (acc[m][0] + bs) * bflo(uv.x) * bflo(gv.x);
      float r1 = (acc[m][1] + bs) * bfhi(uv.x) * bfhi(gv.x);
      float r2 = (acc[m][2] + bs) * bflo(uv.y) * bflo(gv.y);
      float r3 = (acc[m][3] + bs) * bfhi(uv.y) * bfhi(gv.y);
      *(uint2*)(MIX + row * 1024 + c) = make_uint2(pk2(r0, r1), pk2(r2, r3));
    }
  }
}

DEVI void step_attn_task(const Params& p, char* lds, int task) {
  unsigned long wsi_ = (unsigned long)p.ws; asm volatile("" : "+s"(wsi_)); char* ws_ = (char*)(GAS char*)wsi_;
  unsigned long outi_ = (unsigned long)p.out; asm volatile("" : "+s"(outi_)); float* out_ = (float*)(GAS float*)outi_;
  int tid_ = threadIdx.x; asm volatile("" : "+v"(tid_));
  const int tid = tid_, lane = tid & 63, w = tid >> 6, part = lane & 15, ks = lane >> 4;
  const int b = task / 10, hh = task % 10, t = w;
  const int srow = b * 8 + t;
  float* sc = (float*)lds + w * 264;
  const bool dil = hh < 6;
  int nkeys, g = 0, jh = 0, L = 0, sh = 0;
  const float *stbuf = nullptr, *nbuf = nullptr, *q;
  const float* const cm = p.cache_mem;
  if (dil) {
    g = hh >> 1; jh = hh & 1; sh = g * 2; L = 128 << sh; nkeys = 129;
    const float* const a0 = p.st0; const float* const a1 = p.st1; const float* const a2 = p.st2;
    stbuf = g == 0 ? a0 : (g == 1 ? a1 : a2);
    nbuf = out_ + (g == 0 ? O_W0S : (g == 1 ? O_W1S : O_W2S));
    q = (const float*)(ws_ + W_QS) + (long)srow * 384 + hh * 64;
  } else {
    nkeys = 256;
    q = (const float*)(ws_ + W_QCS) + (long)srow * 256 + (hh - 6) * 64;
  }
  auto kvptr = [&](int m, int kv) __attribute__((always_inline)) -> const float* {
    if (dil) {
      int idx = L + t - (m << sh);
      if (idx < L) return stbuf + ((((long)b * L + idx) * 2 + kv) * 2 + jh) * 64;
      return nbuf + ((((long)b * L + (idx - 8)) * 2 + kv) * 2 + jh) * 64;
    } else {
      return cm + ((((long)b * 256 + m) * 2 + kv) * 4 + (hh - 6)) * 64;
    }
  };
  __syncthreads();
  const float4 q4 = *(const float4*)(q + part * 4);
  const int nit = (nkeys + 3) >> 2;
  constexpr int SB = 17;
  for (int it0 = 0; it0 < nit; it0 += SB) {
    float4 kb[SB];
#pragma unroll
    for (int u = 0; u < SB; ++u) {
      int m = min((it0 + u) * 4 + ks, nkeys - 1);
      kb[u] = *(const float4*)(kvptr(m, 0) + part * 4);
    }
#pragma unroll
    for (int u = 0; u < SB; ++u) {
      int m = (it0 + u) * 4 + ks;
      float dot = red16(q4.x * kb[u].x + q4.y * kb[u].y + q4.z * kb[u].z + q4.w * kb[u].w);
      if (part == 0 && m < nkeys) sc[m] = dot;
    }
  }
  __syncthreads();
  float mx = -3.0e38f;
  for (int m = lane; m < nkeys; m += 64) mx = fmaxf(mx, sc[m]);
  mx = wave_max(mx);
  float l = 0.f;
  for (int m = lane; m < nkeys; m += 64) l += __expf(sc[m] - mx);
  l = wave_sum(l);
  const float il = __builtin_amdgcn_rcpf(l);
  __syncthreads();
  for (int m = lane; m < nkeys; m += 64) sc[m] = __expf(sc[m] - mx) * il;
  __syncthreads();
  float4 o4 = make_float4(0.f, 0.f, 0.f, 0.f);
  for (int it0 = 0; it0 < nit; it0 += SB) {
    float4 vb[SB];
    float pm[SB];
#pragma unroll
    for (int u = 0; u < SB; ++u) {
      int m = (it0 + u) * 4 + ks;
      int mc = min(m, nkeys - 1);
      vb[u] = *(const float4*)(kvptr(mc, 1) + part * 4);
      pm[u] = (m < nkeys) ? sc[mc] : 0.f;
    }
#pragma unroll
    for (int u = 0; u < SB; ++u) {
      o4.x += pm[u] * vb[u].x; o4.y += pm[u] * vb[u].y; o4.z += pm[u] * vb[u].z; o4.w += pm[u] * vb[u].w;
    }
  }
  o4.x += __shfl_xor(o4.x, 16); o4.y += __shfl_xor(o4.y, 16); o4.z += __shfl_xor(o4.z, 16); o4.w += __shfl_xor(o4.w, 16);
  o4.x += __shfl_xor(o4.x, 32); o4.y += __shfl_xor(o4.y, 32); o4.z += __shfl_xor(o4.z, 32); o4.w += __shfl_xor(o4.w, 32);
  const long row = PROWS + srow;
  if (ks == 0) {
    if (dil) {
      u16* O = (u16*)(ws_ + W_O);
      *(uint2*)(O + row * 384 + hh * 64 + part * 4) = make_uint2(pk2(o4.x, o4.y), pk2(o4.z, o4.w));
      if (part == 0) ((float*)(ws_ + W_LSE))[row * 6 + hh] = mx + __logf(l);
    } else {
      const int mh = hh - 6;
      const u16* SGC = (const u16*)(ws_ + W_SGC);
      u16* MIX = (u16*)(ws_ + W_MIX);
      uint2 gcv = *(const uint2*)(SGC + row * 256 + mh * 64 + part * 4);
      *(uint2*)(MIX + row * 1024 + 768 + mh * 64 + part * 4) =
          make_uint2(pk2(o4.x * bflo(gcv.x), o4.y * bfhi(gcv.x)), pk2(o4.z * bflo(gcv.y), o4.w * bfhi(gcv.y)));
    }
  }
}

template <bool MEM>
DEVI void shared_attn_task(const Params& p, char* lds, int b, int hh) {
  constexpr int NU = MEM ? 8 : 5, RW = MEM ? 32 : 17, NR = MEM ? 256 : 136, SCS = 264;
  unsigned long wsi_ = (unsigned long)p.ws; asm volatile("" : "+s"(wsi_)); char* ws_ = (char*)(GAS char*)wsi_;
  unsigned long outi_ = (unsigned long)p.out; asm volatile("" : "+s"(outi_)); float* out_ = (float*)(GAS float*)outi_;
  int tid_ = threadIdx.x; asm volatile("" : "+v"(tid_));
  const int tid = tid_, lane = tid & 63, w = tid >> 6, part = lane & 15, ks = lane >> 4;
  float* sc = (float*)lds;
  float* red = (float*)lds + 8 * SCS;
  const int mh = hh - 6, jh = hh & 1;
  const float* const cm = p.cache_mem;
  const float* const s0 = p.st0;
  const float* const nb0 = out_ + O_W0S;
  auto rowptr = [&](int r, int kv) __attribute__((always_inline)) -> const float* {
    if (MEM) return cm + ((((long)b * 256 + r) * 2 + kv) * 4 + mh) * 64;
    if (r < 128) return s0 + ((((long)b * 128 + r) * 2 + kv) * 2 + jh) * 64;
    return nb0 + ((((long)b * 128 + (r - 8)) * 2 + kv) * 2 + jh) * 64;
  };
  float4 kb[NU], vb[NU];
#pragma unroll
  for (int u = 0; u < NU; ++u) {
    int r = min(w * RW + u * 4 + ks, NR - 1);
    kb[u] = *(const float4*)(rowptr(r, 0) + part * 4);
    vb[u] = *(const float4*)(rowptr(r, 1) + part * 4);
  }
  float4 q4[8];
#pragma unroll
  for (int t = 0; t < 8; ++t) {
    const float* q = MEM ? (const float*)(ws_ + W_QCS) + (long)(b * 8 + t) * 256 + mh * 64 : (const float*)(ws_ + W_QS) + (long)(b * 8 + t) * 384 + hh * 64;
    q4[t] = *(const float4*)(q + part * 4);
  }
  __syncthreads();
#pragma unroll
  for (int u = 0; u < NU; ++u) {
    float d[8];
#pragma unroll
    for (int t = 0; t < 8; ++t) {
      float x = q4[t].x * kb[u].x + q4[t].y * kb[u].y + q4[t].z * kb[u].z + q4[t].w * kb[u].w;
      d[t] = red16(x);
    }
    const int pt = part & 7;
    float v = d[0];
    v = pt == 1 ? d[1] : v; v = pt == 2 ? d[2] : v; v = pt == 3 ? d[3] : v; v = pt == 4 ? d[4] : v;
    v = pt == 5 ? d[5] : v; v = pt == 6 ? d[6] : v; v = pt == 7 ? d[7] : v;
    const int rl = u * 4 + ks, r = w * RW + rl;
    if (part < 8 && rl < RW && r < NR) {
      if (!MEM && !(r >= part && r <= part + 128)) v = NEGV;
      sc[part * SCS + r] = v;
    }
  }
  __syncthreads();
  {
    const int t = w;
    float mx = -3.0e38f;
    for (int m = lane; m < NR; m += 64) mx = fmaxf(mx, sc[t * SCS + m]);
    mx = wave_max(mx);
    float l = 0.f;
    for (int m = lane; m < NR; m += 64) l += __expf(sc[t * SCS + m] - mx);
    l = wave_sum(l);
    const float il = __builtin_amdgcn_rcpf(l);
    for (int m = lane; m < NR; m += 64) sc[t * SCS + m] = __expf(sc[t * SCS + m] - mx) * il;
    if (!MEM && lane == 0) ((float*)(ws_ + W_LSE))[(long)(PROWS + b * 8 + t) * 6 + hh] = mx + __logf(l);
  }
  __syncthreads();
  float4 o[8];
#pragma unroll
  for (int t = 0; t < 8; ++t) o[t] = make_float4(0.f, 0.f, 0.f, 0.f);
#pragma unroll
  for (int u = 0; u < NU; ++u) {
    const int rl = u * 4 + ks, r = w * RW + rl;
    const bool valid = rl < RW && r < NR;
    const int rc = min(r, NR - 1);
#pragma unroll
    for (int t = 0; t < 8; ++t) {
      float pm = valid ? sc[t * SCS + rc] : 0.f;
      o[t].x += pm * vb[u].x; o[t].y += pm * vb[u].y; o[t].z += pm * vb[u].z; o[t].w += pm * vb[u].w;
    }
  }
#pragma unroll
  for (int t = 0; t < 8; ++t) *(float4*)(red + ((w * 4 + ks) * 8 + t) * 64 + part * 4) = o[t];
  __syncthreads();
  {
    const int t = tid >> 6, d = tid & 63;
    float acc = 0.f;
#pragma unroll
    for (int ww = 0; ww < 32; ++ww) acc += red[(ww * 8 + t) * 64 + d];
    const long row = PROWS + b * 8 + t;
    if (MEM) {
      const u16* SGC = (const u16*)(ws_ + W_SGC);
      ((u16*)(ws_ + W_MIX))[row * 1024 + 768 + mh * 64 + d] = f2bf(acc * bf2f(SGC[row * 256 + mh * 64 + d]));
    } else {
      ((u16*)(ws_ + W_O))[row * 384 + hh * 64 + d] = f2bf(acc);
    }
  }
}

DEVI void sample_gmlp_task(const Params& p, char* lds, int b) {
  unsigned long wsi_ = (unsigned long)p.ws; asm volatile("" : "+s"(wsi_)); char* ws_ = (char*)(GAS char*)wsi_;
  unsigned long outi_ = (unsigned long)p.out; asm volatile("" : "+s"(outi_)); float* out_ = (float*)(GAS float*)outi_;
  int tid_ = threadIdx.x; asm volatile("" : "+v"(tid_)); const int tid = tid_;
  float* mu = (float*)lds;
  float* rstd = mu + 8;
  const float* VSTAT = (const float*)(ws_ + W_VSTAT);
  const u16* GV = (const u16*)(ws_ + W_GV);
  __syncthreads();
  if (tid < 8) {
    long row = PROWS + b * 8 + tid;
    float s1 = 0.f, s2 = 0.f;
    for (int i = 0; i < 6; ++i) { float2 v = *(const float2*)(VSTAT + (row * 6 + i) * 2); s1 += v.x; s2 += v.y; }
    float m = s1 * (1.f / 384.f);
    float var = fmaxf(s2 * (1.f / 384.f) - m * m, 0.f);
    mu[tid] = m; rstd[tid] = rsqrtf(var + EPS);
  }
  __syncthreads();
  const u16* U = (const u16*)(ws_ + W_U);
  const u16* SGA = (const u16*)(ws_ + W_SGA);
  u16* MIX = (u16*)(ws_ + W_MIX);
  float* gvout = out_ + O_GV;
  if (tid < 384) {
    const int c = tid, g = c >> 6;
    float lg = p.ln_g[c], lb = p.ln_b[c];
    float v[8];
#pragma unroll
    for (int s = 0; s < 8; ++s) {
      long row = PROWS + b * 8 + s;
      v[s] = (bf2f(GV[row * 384 + c]) - mu[s]) * rstd[s] * lg + lb;
      gvout[((long)b * 8 + s) * 384 + c] = v[s];
    }
#pragma unroll
    for (int t = 0; t < 8; ++t) {
      float sacc = p.b_s[g * 128 + t];
#pragma unroll
      for (int s = 0; s < 8; ++s)
        if (s <= t) sacc += p.w_s[((long)g * 128 + t) * 128 + s] * v[s];
      long row = PROWS + b * 8 + t;
      float r = sacc * bf2f(U[row * 384 + c]) * bf2f(SGA[row * 384 + c]);
      MIX[row * 1024 + c] = f2bf(r);
    }
  }
}

constexpr int NCOPY = 128 * (1 + 4 + 16);
DEVI void do_copy(const Params& p, int task) {
  const float* const a0 = p.st0; const float* const a1 = p.st1; const float* const a2 = p.st2; float* const po = p.out;
  int g, b, c, L, nch;
  const float* src; float* dst;
  if (task < 2048) { g = 2; b = task >> 4; c = task & 15; L = 2048; nch = 16; src = a2; dst = po + O_W2S; }
  else if (task < 2560) { g = 1; b = (task - 2048) >> 2; c = (task - 2048) & 3; L = 512; nch = 4; src = a1; dst = po + O_W1S; }
  else { g = 0; b = task - 2560; c = 0; L = 128; nch = 1; src = a0; dst = po + O_W0S; }
  (void)g;
  const f32x4* sp = (const f32x4*)src + ((long)b * L + 8) * 64 + (long)c * 8192 + threadIdx.x;
  f32x4* dp = (f32x4*)dst + (long)b * L * 64 + (long)c * 8192 + threadIdx.x;
  const bool last = (c == nch - 1);
  f32x4 v[16];
#pragma unroll
  for (int u = 0; u < 15; ++u) v[u] = __builtin_nontemporal_load(sp + u * 512);
  if (!last) v[15] = __builtin_nontemporal_load(sp + 15 * 512);
#pragma unroll
  for (int u = 0; u < 15; ++u) __builtin_nontemporal_store(v[u], dp + u * 512);
  if (!last) __builtin_nontemporal_store(v[15], dp + 15 * 512);
}
DEVI void copier_loop(const Params& p, char* lds, unsigned* ctl, int done_idx, unsigned done_target) {
  volatile unsigned* slot = (volatile unsigned*)lds;
  for (;;) {
    __syncthreads();
    if (threadIdx.x == 0) {
      unsigned t = NCOPY;
      if (done_target == 0u || xb_ld(&ctl[done_idx]) < done_target) t = xb_add(&ctl[CTL_COPY_HEAD], 1u);
      *slot = t;
    }
    __syncthreads();
    const unsigned t = *slot;
    if (t >= (unsigned)NCOPY) break;
    do_copy(p, (int)t);
  }
}

DEVI void phase3(const Params& p) {
  const int total = ROWS * 96;
  const u16* O = (const u16*)(p.ws + W_O);
  const u16* SGB = (const u16*)(p.ws + W_SGB);
  const float* LSE = (const float*)(p.ws + W_LSE);
  u16* MIX = (u16*)(p.ws + W_MIX);
  const int stride = gridDim.x * NT;
  for (int idx0 = blockIdx.x * NT + threadIdx.x; idx0 < total; idx0 += 4 * stride) {
    float l0[4], l1[4], l2[4];
    uint2 ov[4], gv[4];
    int rowv[4], cv[4];
#pragma unroll
    for (int q = 0; q < 4; ++q) {
      const int idx = min(idx0 + q * stride, total - 1);
      const int row = idx / 96, c = (idx - row * 96) * 4, jh = (c >> 6) & 1;
      rowv[q] = row; cv[q] = c;
      l0[q] = LSE[(long)row * 6 + jh]; l1[q] = LSE[(long)row * 6 + 2 + jh]; l2[q] = LSE[(long)row * 6 + 4 + jh];
      ov[q] = *(const uint2*)(O + (long)row * 384 + c);
      gv[q] = *(const uint2*)(SGB + (long)row * 384 + c);
    }
#pragma unroll
    for (int q = 0; q < 4; ++q) {
      if (idx0 + q * stride < total) {
        const int g = cv[q] >> 7;
        float mx = fmaxf(l0[q], fmaxf(l1[q], l2[q]));
        float e0 = __expf(l0[q] - mx), e1 = __expf(l1[q] - mx), e2 = __expf(l2[q] - mx);
        float wgt = (g == 0 ? e0 : (g == 1 ? e1 : e2)) * __builtin_amdgcn_rcpf(e0 + e1 + e2);
        float r0 = bflo(ov[q].x) * wgt * bflo(gv[q].x), r1 = bfhi(ov[q].x) * wgt * bfhi(gv[q].x);
        float r2 = bflo(ov[q].y) * wgt * bflo(gv[q].y), r3 = bfhi(ov[q].y) * wgt * bfhi(gv[q].y);
        *(uint2*)(MIX + (long)rowv[q] * 1024 + 384 + cv[q]) = make_uint2(pk2(r0, r1), pk2(r2, r3));
      }
    }
  }
}

DEVI void phase4_tile(const Params& p, char* lds, int tile) {
  unsigned long wsi_ = (unsigned long)p.ws; asm volatile("" : "+s"(wsi_)); char* ws_ = (char*)(GAS char*)wsi_;
  unsigned long outi_ = (unsigned long)p.out; asm volatile("" : "+s"(outi_)); float* out_ = (float*)(GAS float*)outi_;
  int tid_ = threadIdx.x; asm volatile("" : "+v"(tid_));
  const int tid = tid_, lane = tid & 63, wid = tid >> 6, wr = wid >> 2, wc = wid & 3, fr = lane & 15, fq = lane >> 4;
  const int mt = tile >> 2, nt = tile & 3;
  f32x4 acc[2][2][4][2];
  gemm256((const u16*)(ws_ + W_WOUTT) + (long)nt * 256 * 1024, (const u16*)(ws_ + W_MIX) + (long)mt * 256 * 1024, acc, lds, tid);
  const float* const xp_ = p.x_prompt; const float* const xs_ = p.x_sample;
#pragma unroll
  for (int bj = 0; bj < 2; ++bj)
#pragma unroll
    for (int n = 0; n < 2; ++n) {
      long tok = mt * 256 + bj * 128 + wc * 32 + n * 16 + fr;
      const float* xr = tok < PROWS ? xp_ + tok * 1024 : xs_ + (tok - PROWS) * 1024;
      float* yr = tok < PROWS ? out_ + O_YP + tok * 1024 : out_ + O_YS + (tok - PROWS) * 1024;
#pragma unroll
      for (int ai = 0; ai < 2; ++ai)
#pragma unroll
        for (int m = 0; m < 4; ++m) {
          int col = nt * 256 + ai * 128 + wr * 64 + m * 16 + fq * 4;
          float4 xv = *(const float4*)(xr + col);
          f32x4 a = acc[ai][bj][m][n];
          *(float4*)(yr + col) = make_float4(xv.x + a[0], xv.y + a[1], xv.z + a[2], xv.w + a[3]);
        }
    }
}

constexpr int P1_GEMM_BLOCKS = 224;
constexpr int P4_GEMM_BLOCKS = 136;
__global__ void __launch_bounds__(NT) fwd_kernel(Params p) {
  extern __shared__ __attribute__((aligned(16))) char lds[];
  __shared__ uint4 xb_words;
  const int G = gridDim.x;
  unsigned* ctl = (unsigned*)(p.ws + W_CTL);
  if (threadIdx.x == 0) xb_words = make_uint4(0u, 0u, 0u, 0u);
  __syncthreads();
  XcdBarrier xb = xcd_barrier_post(ctl, (volatile LAS unsigned*)&xb_words);
  if (p.phase_hi == 99) cg::this_grid().sync();
  phase0(p);
  xcd_barrier(xb);
  {
    const int gb = G > P1_GEMM_BLOCKS ? P1_GEMM_BLOCKS : G;
    if ((int)blockIdx.x < gb) {
      int t_beg = blockIdx.x, t_end = P1_ALL, t_step = gb;
      if ((gb & 7) == 0) {
        const int x = blockIdx.x & 7;
        t_beg = ((P1_ALL * x) >> 3) + (blockIdx.x >> 3); t_end = (P1_ALL * (x + 1)) >> 3; t_step = gb >> 3;
      }
      for (int tile = t_beg; tile < t_end; tile += t_step) {
        phase1_tile(p, lds, tile);
        if (threadIdx.x == 0) xb_add(&ctl[CTL_P1_DONE], 1u);
      }
    } else {
      copier_loop(p, lds, ctl, CTL_P1_DONE, (unsigned)P1_ALL);
    }
  }
  xcd_barrier(xb);
  {
    constexpr int T0 = 768, T1 = T0 + 512, T2 = T1 + 768, T3 = T2 + 1280, T4 = T3 + 128;
    const int nk = (T4 + G - 1) / G;
    const int rot = (blockIdx.x >> 3) % nk;
    for (int kk = 0; kk < nk; ++kk) {
      int kx = kk + rot; if (kx >= nk) kx -= nk;
      const int task = blockIdx.x + kx * G;
      if (task >= T4) continue;
      if (task < T0) attn_task<true>(p, lds, task);
      else if (task < T1) attn_task<false>(p, lds, task - T0);
      else if (task < T2) gmlp_task(p, lds, task - T1);
      else if (task < T3) {
        const int st = task - T2, sb = st / 10, shh = st % 10;
        if (shh < 2) shared_attn_task<false>(p, lds, sb, shh);
        else if (shh >= 6) shared_attn_task<true>(p, lds, sb, shh);
        else step_attn_task(p, lds, st);
      }
      else sample_gmlp_task(p, lds, task - T3);
    }
  }
  xcd_barrier(xb);
  phase3(p);
  xcd_barrier(xb);
  {
    __syncthreads();
    const int gb = G > P4_GEMM_BLOCKS ? P4_GEMM_BLOCKS : G;
    if ((int)blockIdx.x < gb) {
      int t_beg = blockIdx.x, t_end = 272, t_step = gb;
      if ((gb & 7) == 0) {
        const int x = blockIdx.x & 7;
        t_beg = ((272 * x) >> 3) + (blockIdx.x >> 3); t_end = (272 * (x + 1)) >> 3; t_step = gb >> 3;
      }
      for (int tile = t_beg; tile < t_end; tile += t_step) {
        phase4_tile(p, lds, tile);
        if (threadIdx.x == 0) xb_add(&ctl[CTL_P4_DONE], 1u);
      }
    } else {
      copier_loop(p, lds, ctl, CTL_P4_DONE, 68u * 4u);
    }
    copier_loop(p, lds, ctl, 0, 0u);
  }
}

extern "C" void kernel_launch(void* const* d_in, const int* in_sizes, int n_in, void* d_out, int out_size, void* d_ws, size_t ws_size,
                              hipStream_t stream) {
  static int grid_blocks = 0;
  if (!grid_blocks) {
    int dev = 0, cus = 0, per_cu = 0;
    (void)hipGetDevice(&dev);
    (void)hipDeviceGetAttribute(&cus, hipDeviceAttributeMultiprocessorCount, dev);
    (void)hipFuncSetAttribute((const void*)fwd_kernel, hipFuncAttributeMaxDynamicSharedMemorySize, LDS_BYTES);
    (void)hipOccupancyMaxActiveBlocksPerMultiprocessor(&per_cu, (const void*)fwd_kernel, NT, LDS_BYTES);
    if (per_cu < 1) { fprintf(stderr, "occupancy query reports %d blocks/CU\n", per_cu); per_cu = 1; }
    if (per_cu > 1) per_cu = 1;
    grid_blocks = cus * per_cu;
    if (ws_size < W_END) fprintf(stderr, "workspace too small: %zu < %zu\n", ws_size, (size_t)W_END);
  }
  Params p{};
  p.x_prompt = (const float*)d_in[0]; p.x_sample = (const float*)d_in[1];
  p.st0 = (const float*)d_in[2]; p.st1 = (const float*)d_in[3]; p.st2 = (const float*)d_in[4];
  p.cache_mem = (const float*)d_in[5]; p.mem_prompt = (const float*)d_in[6]; p.norm_gain = (const float*)d_in[7];
  p.w_in = (const float*)d_in[8]; p.ln_g = (const float*)d_in[9]; p.ln_b = (const float*)d_in[10];
  p.w_s = (const float*)d_in[11]; p.b_s = (const float*)d_in[12]; p.q_norm = (const float*)d_in[13];
  p.k_norm = (const float*)d_in[14]; p.mem_norm = (const float*)d_in[15]; p.w_mem_kv = (const float*)d_in[16];
  p.mem_q_norm = (const float*)d_in[17]; p.mem_k_norm = (const float*)d_in[18]; p.w_out = (const float*)d_in[19];
  p.out = (float*)d_out; p.ws = (char*)d_ws;
  p.phase_lo = 0; p.phase_hi = 5;
  (void)hipMemsetAsync((char*)d_ws + W_CTL, 0, CTL_BYTES, stream);
  void* args[] = {&p};
  hipError_t e = hipLaunchCooperativeKernel((const void*)fwd_kernel, dim3(grid_blocks), dim3(NT), args, LDS_BYTES, stream);
  if (e != hipSuccess) fprintf(stderr, "cooperative launch failed: %s (grid %d)\n", hipGetErrorString(e), grid_blocks);
}
```
